# Optimizing an MI355X kernel written in HIP

```python
import math
import jax, jax.numpy as jnp
from jax import lax
import numpy as np

D_MODEL = 1024
BATCH = 4
SEQ = 8192
DEPTH = 4

CHUNK = 64
N_MIXERS = 4
RMS_EPS = 1e-6

A_HEADS = 16
A_HEAD_DIM = D_MODEL // A_HEADS
A_WIDTH = A_HEADS * A_HEAD_DIM
A_LEFT_CHUNKS = 8
A_BAND = (A_LEFT_CHUNKS + 1) * CHUNK
A_MAX_REL = 256
A_REL_SIZE = (CHUNK - 1) + A_MAX_REL + 1

SG_FF = 6 * D_MODEL
SG_HALF = SG_FF // 2
SG_GROUPS = 8
SG_WINDOW = 128

GLA_HEADS = 4
GLA_KEY_WIDTH = D_MODEL // 2
GLA_VALUE_WIDTH = D_MODEL
GLA_DK = GLA_KEY_WIDTH // GLA_HEADS
GLA_DV = GLA_VALUE_WIDTH // GLA_HEADS
GLA_GATE_RANK = 16
GLA_TAU = 16.0
GLA_IN_WIDTH = 2 * GLA_KEY_WIDTH + 2 * GLA_VALUE_WIDTH + GLA_GATE_RANK

SB_HEADS = 16
SB_HEAD_DIM = D_MODEL // SB_HEADS
SB_WIDTH = SB_HEADS * SB_HEAD_DIM
SB_BLOCK = 128

FFN_HIDDEN = 4 * D_MODEL

kernel_name = "hybrid_chunk_causal_interleaved_trunk"


def rms_norm(x, gain):
    xf = x.astype(jnp.float32)
    y = xf * lax.rsqrt(jnp.mean(xf * xf, axis=-1, keepdims=True) + RMS_EPS)
    return (y * gain.astype(jnp.float32)).astype(x.dtype)


def chunked_relpos_attention(h, w_in, q_gain, k_gain, rel_bias, w_out):
    B, S, _ = h.shape
    nc = S // CHUNK
    q, k, v = jnp.split(h @ w_in, 3, axis=-1)
    q = rms_norm(q.reshape(B, S, A_HEADS, A_HEAD_DIM), q_gain) * (A_HEAD_DIM ** -0.5)
    k = rms_norm(k.reshape(B, S, A_HEADS, A_HEAD_DIM), k_gain)
    v = v.reshape(B, S, A_HEADS, A_HEAD_DIM)
    pad = A_LEFT_CHUNKS * CHUNK
    kp = jnp.pad(k, ((0, 0), (pad, 0), (0, 0), (0, 0)))
    vp = jnp.pad(v, ((0, 0), (pad, 0), (0, 0), (0, 0)))
    rel = jnp.arange(CHUNK)[:, None] + pad - jnp.arange(A_BAND)[None, :]
    bias_idx = jnp.clip(rel, -(CHUNK - 1), A_MAX_REL) + (CHUNK - 1)
    bias = rel_bias.astype(jnp.float32)[:, bias_idx]

    def one_chunk(ci):
        start = ci * CHUNK
        qc = lax.dynamic_slice_in_dim(q, start, CHUNK, axis=1)
        kb = lax.dynamic_slice_in_dim(kp, start, A_BAND, axis=1)
        vb = lax.dynamic_slice_in_dim(vp, start, A_BAND, axis=1)
        s = jnp.einsum('bihd,bjhd->bhij', qc, kb).astype(jnp.float32) + bias
        valid = (start + jnp.arange(A_BAND)) >= pad
        s = jnp.where(valid[None, None, None, :], s, -jnp.inf)
        p = jax.nn.softmax(s, axis=-1).astype(vb.dtype)
        return jnp.einsum('bhij,bjhd->bihd', p, vb)

    o = lax.map(one_chunk, jnp.arange(nc))
    o = o.transpose(1, 0, 2, 3, 4).reshape(B, S, A_WIDTH)
    return o @ w_out


def chunked_spatial_gating(h, w_in, v_gain, w_s, b_s, w_out):
    B, S, _ = h.shape
    nw = S // SG_WINDOW
    z = jax.nn.gelu(h @ w_in, approximate=False)
    u, v = jnp.split(z, 2, axis=-1)
    v = rms_norm(v, v_gain).reshape(B, nw, SG_WINDOW, SG_GROUPS, SG_HALF // SG_GROUPS)
    chunk_id = jnp.arange(SG_WINDOW) // CHUNK
    mask = chunk_id[:, None] >= chunk_id[None, :]
    w = jnp.where(mask[None], w_s, 0.0).astype(v.dtype)
    vm = jnp.einsum('gij,bnjgc->bnigc', w, v) + b_s.T.astype(v.dtype)[None, None, :, :, None]
    return (u * vm.reshape(B, S, SG_HALF)) @ w_out


def gated_linear_attention(h, w_in, w_gate_up, b_gate, o_gain, w_out):
    B, S, _ = h.shape
    nc = S // CHUNK
    splits = [GLA_KEY_WIDTH, 2 * GLA_KEY_WIDTH, 2 * GLA_KEY_WIDTH + GLA_VALUE_WIDTH,
              2 * GLA_KEY_WIDTH + 2 * GLA_VALUE_WIDTH]
    q, k, v, r, a = jnp.split(h @ w_in, splits, axis=-1)
    log_alpha = jax.nn.log_sigmoid((a @ w_gate_up + b_gate).astype(jnp.float32)) / GLA_TAU

    def to_chunks(t, d):
        return t.reshape(B, nc, CHUNK, GLA_HEADS, d).transpose(1, 0, 3, 2, 4).astype(jnp.float32)

    qc = to_chunks(q, GLA_DK) * (GLA_DK ** -0.5)
    kc = to_chunks(k, GLA_DK)
    vc = to_chunks(v, GLA_DV)
    bc = jnp.cumsum(to_chunks(log_alpha, GLA_DK), axis=3)
    causal = jnp.tril(jnp.ones((CHUNK, CHUNK), dtype=bool))

    def step(state, inp):
        qt, kt, vt, bt = inp
        o_inter = jnp.einsum('bhtk,bhkv->bhtv', qt * jnp.exp(bt), state)
        decay = bt[:, :, :, None, :] - bt[:, :, None, :, :]
        decay = jnp.exp(jnp.where(causal[None, None, :, :, None], decay, -jnp.inf))
        att = jnp.einsum('bhtk,bhsk,bhtsk->bhts', qt, kt, decay)
        o_intra = jnp.einsum('bhts,bhsv->bhtv', att, vt)
        b_last = bt[:, :, -1:, :]
        k_dec = kt * jnp.exp(b_last - bt)
        state = state * jnp.exp(b_last[:, :, 0, :])[..., None] + jnp.einsum('bhsk,bhsv->bhkv', k_dec, vt)
        return state, o_inter + o_intra

    state0 = jnp.zeros((B, GLA_HEADS, GLA_DK, GLA_DV), jnp.float32)
    _, o = lax.scan(step, state0, (qc, kc, vc, bc))
    o = o.transpose(1, 0, 3, 2, 4).reshape(B, S, GLA_HEADS, GLA_DV).astype(h.dtype)
    o = rms_norm(o, o_gain).reshape(B, S, GLA_VALUE_WIDTH)
    return (jax.nn.silu(r) * o) @ w_out


def stick_breaking_attention(h, w_in, w_out):
    B, S, _ = h.shape
    q, k, v = jnp.split(h @ w_in, 3, axis=-1)
    q = q.reshape(B, S, SB_HEADS, SB_HEAD_DIM).transpose(0, 2, 1, 3)
    k = k.reshape(B, S, SB_HEADS, SB_HEAD_DIM).transpose(0, 2, 1, 3)
    v = v.reshape(B, S, SB_HEADS, SB_HEAD_DIM).transpose(0, 2, 1, 3)
    scale = SB_HEAD_DIM ** -0.5
    outs = []
    for blk in range(S // SB_BLOCK):
        q0 = blk * SB_BLOCK
        kend = q0 + SB_BLOCK
        z = jnp.einsum('bhtd,bhsd->bhts', q[:, :, q0:kend], k[:, :, :kend]).astype(jnp.float32) * scale
        t_pos = q0 + jnp.arange(SB_BLOCK)
        strict = jnp.arange(kend)[None, :] < t_pos[:, None]
        log_not = jnp.where(strict, jax.nn.log_sigmoid(-z), 0.0)
        tail = lax.cumsum(log_not, axis=3, reverse=True)
        excl = jnp.concatenate([tail[..., 1:], jnp.zeros_like(tail[..., :1])], axis=-1)
        weights = jnp.where(strict, jnp.exp(jax.nn.log_sigmoid(z) + excl), 0.0)
        outs.append(jnp.einsum('bhts,bhsd->bhtd', weights.astype(v.dtype), v[:, :, :kend]))
    o = jnp.concatenate(outs, axis=2).transpose(0, 2, 1, 3).reshape(B, S, SB_WIDTH)
    return o @ w_out


def squared_relu_mlp(h, w1, w2):
    return jnp.square(jax.nn.relu(h @ w1)) @ w2


def _n_mixer_layers(m):
    return len(range(m, DEPTH, N_MIXERS))


def setup_inputs(seed: int = 0) -> dict:
    key = jax.random.key(seed)
    keys = iter(jax.random.split(key, 32))
    D = D_MODEL

    def nrm(shape, scale):
        return jax.random.normal(next(keys), shape, jnp.float32) * scale

    nA, nB, nC, nD = (_n_mixer_layers(m) for m in range(N_MIXERS))
    return {
        "x": nrm((BATCH, SEQ, D), 1.0),
        "c": nrm((BATCH, D), 1.0),
        "ada_w": nrm((DEPTH, D, 6 * D), 0.5 * D ** -0.5),
        "ada_b": nrm((DEPTH, 6 * D), 0.02),
        "norm_mix": 1.0 + nrm((DEPTH, D), 0.05),
        "norm_ffn": 1.0 + nrm((DEPTH, D), 0.05),
        "ffn_w1": nrm((DEPTH, D, FFN_HIDDEN), D ** -0.5),
        "ffn_w2": nrm((DEPTH, FFN_HIDDEN, D), FFN_HIDDEN ** -0.5),
        "a_w_in": nrm((nA, D, 3 * A_WIDTH), D ** -0.5),
        "a_q_gain": 1.0 + nrm((nA, A_HEAD_DIM), 0.05),
        "a_k_gain": 1.0 + nrm((nA, A_HEAD_DIM), 0.05),
        "a_rel_bias": nrm((nA, A_HEADS, A_REL_SIZE), 0.5),
        "a_w_out": nrm((nA, A_WIDTH, D), A_WIDTH ** -0.5),
        "b_w_in": nrm((nB, D, SG_FF), D ** -0.5),
        "b_v_gain": 1.0 + nrm((nB, SG_HALF), 0.05),
        "b_w_s": nrm((nB, SG_GROUPS, SG_WINDOW, SG_WINDOW), SG_WINDOW ** -0.5),
        "b_b_s": 1.0 + nrm((nB, SG_GROUPS, SG_WINDOW), 0.05),
        "b_w_out": nrm((nB, SG_HALF, D), SG_HALF ** -0.5),
        "c_w_in": nrm((nC, D, GLA_IN_WIDTH), D ** -0.5),
        "c_w_gate_up": nrm((nC, GLA_GATE_RANK, GLA_KEY_WIDTH), GLA_GATE_RANK ** -0.5),
        "c_b_gate": nrm((nC, GLA_KEY_WIDTH), 0.02),
        "c_o_gain": 1.0 + nrm((nC, GLA_DV), 0.05),
        "c_w_out": nrm((nC, GLA_VALUE_WIDTH, D), GLA_VALUE_WIDTH ** -0.5),
        "d_w_in": nrm((nD, D, 3 * SB_WIDTH), D ** -0.5),
        "d_w_out": nrm((nD, SB_WIDTH, D), SB_WIDTH ** -0.5),
    }


def reference(x, c, ada_w, ada_b, norm_mix, norm_ffn, ffn_w1, ffn_w2,
              a_w_in, a_q_gain, a_k_gain, a_rel_bias, a_w_out,
              b_w_in, b_v_gain, b_w_s, b_b_s, b_w_out,
              c_w_in, c_w_gate_up, c_b_gate, c_o_gain, c_w_out,
              d_w_in, d_w_out):
    cond = jax.nn.silu(c)
    for i in range(DEPTH):
        m, j = i % N_MIXERS, i // N_MIXERS
        mod = cond @ ada_w[i] + ada_b[i]
        sh1, sc1, g1, sh2, sc2, g2 = [t[:, None, :] for t in jnp.split(mod, 6, axis=-1)]
        h = rms_norm(x, norm_mix[i]) * (1.0 + sc1) + sh1
        if m == 0:
            y = chunked_relpos_attention(h, a_w_in[j], a_q_gain[j], a_k_gain[j], a_rel_bias[j], a_w_out[j])
        elif m == 1:
            y = chunked_spatial_gating(h, b_w_in[j], b_v_gain[j], b_w_s[j], b_b_s[j], b_w_out[j])
        elif m == 2:
            y = gated_linear_attention(h, c_w_in[j], c_w_gate_up[j], c_b_gate[j], c_o_gain[j], c_w_out[j])
        else:
            y = stick_breaking_attention(h, d_w_in[j], d_w_out[j])
        x = x + g1 * y
        h = rms_norm(x, norm_ffn[i]) * (1.0 + sc2) + sh2
        x = x + g2 * squared_relu_mlp(h, ffn_w1[i], ffn_w2[i])
    return x
```

```cpp
#include <hip/hip_runtime.h>
#include <hip/hip_cooperative_groups.h>
#include <cstdio>
#include <cstdint>
namespace cg = cooperative_groups;

#ifndef MULTI_LAUNCH
#define MULTI_LAUNCH 0
#endif

#define LAS __attribute__((address_space(3)))
typedef unsigned short bf16_t;
typedef short bf16x8 __attribute__((ext_vector_type(8)));
typedef float f32x4 __attribute__((ext_vector_type(4)));
typedef float f32x2 __attribute__((ext_vector_type(2)));
typedef unsigned u32x4 __attribute__((ext_vector_type(4)));
typedef unsigned u32x2 __attribute__((ext_vector_type(2)));

namespace pg8 {
constexpr int BM = 256, BK = 64, HALF = 128, HTB = HALF * BK * 2, STAGE_BYTES = 8 * HTB, NXCD = 8, WGM = 8;
__host__ __device__ __forceinline__ int lds_byte(int r, int c) { const int st = (r >> 4) * 2 + (c >> 5), rr = r & 15, cc = c & 31, ob = rr * 64 + cc * 2; return st * 1024 + (ob ^ (((ob >> 9) & 1) << 5)); }
__host__ __device__ __forceinline__ void stage_rc(int b, int& R, int& C) { const int st = b / 1024, sb = b % 1024, swz = sb ^ (((sb >> 9) & 1) << 5); R = (st >> 1) * 16 + swz / 64; C = (st & 1) * 32 + (swz % 64) / 2; }
__host__ __device__ __forceinline__ int perm32(int rho) { const int n = rho >> 4, i = rho & 15; return 8 * (i >> 2) + 4 * n + (i & 3); }
struct Unit { int pm, pn; };
struct Gemm { const bf16_t* A; const bf16_t* Bt; int M, N, K; };
struct StaticOrder {
    int nM, nN, nwg, G, c;
    __host__ __device__ void init(int M, int N, int G_, int c_) { nM = M / BM; nN = N / BM; nwg = nM * nN; G = G_; c = c_; }
    __host__ __device__ bool next(int i, Unit& u) const {
        const int L = i * G + c; if (L >= nwg) return false;
        int wgid = L; { const int q = nwg / NXCD, r = nwg % NXCD, xcd = wgid % NXCD, off = wgid / NXCD; wgid = (xcd < r ? xcd * (q + 1) : r * (q + 1) + (xcd - r) * q) + off; }
        const int nig = WGM * nN, gid = wgid / nig, fm = gid * WGM, gsz = (nM - fm) < WGM ? (nM - fm) : WGM, gsh = (gsz == 8) ? 3 : 2, w = wgid - gid * nig;
        u.pm = fm + (w & (gsz - 1)); u.pn = w >> gsh;
#if defined(__HIP_DEVICE_COMPILE__)
        u.pm = __builtin_amdgcn_readfirstlane(u.pm); u.pn = __builtin_amdgcn_readfirstlane(u.pn);
#endif
        return true;
    }
    __device__ __forceinline__ void a_ready(const Unit&) const {}
    __device__ __forceinline__ void done(const Unit&) const {}
};
typedef __bf16 bf16v2 __attribute__((ext_vector_type(2)));
__device__ __forceinline__ unsigned cvt_pk_bf16(float lo, float hi) { const f32x2 v = {lo, hi}; const bf16v2 b = __builtin_convertvector(v, bf16v2); return __builtin_bit_cast(unsigned, b); }
__device__ __forceinline__ void st16_wt(void* base, unsigned byte_off, u32x4 v) {
    const __amdgpu_buffer_rsrc_t r = __builtin_amdgcn_make_buffer_rsrc(base, 0, 0x7ffffff0, 0x00020000);
    __builtin_amdgcn_raw_buffer_store_b128(v, r, (int)byte_off, 0, 16);
}
__device__ __forceinline__ f32x2 gelu_pk(f32x2 v) {
    const f32x2 av = __builtin_elementwise_abs(v), d = av * 0.2316418882f + 1.0f;
    f32x2 t; t.x = __builtin_amdgcn_rcpf(d.x); t.y = __builtin_amdgcn_rcpf(d.y);
    f32x2 q = t * 0.5307027145f + (-0.7265760135f); q = q * t + 0.7107068705f; q = q * t + (-0.142248368f); q = q * t + 0.127414796f; q = q * t;
    const f32x2 s = (v * v) * (-0.72134752044f);
    f32x2 e; e.x = __builtin_amdgcn_exp2f(s.x); e.y = __builtin_amdgcn_exp2f(s.y);
    const f32x2 m = v * (q * e), r = v - m;
    f32x2 o; o.x = v.x < 0.f ? m.x : r.x; o.y = v.y < 0.f ? m.y : r.y; return o;
}

template <int ACT, bool COLSUM, bool BLK = false, int sr = 0, int sc = 0, int a_pn = (1 << 30)> struct EpiBf {
    static constexpr bool PERM = true, AFTER_DRAIN = false;
    bf16_t* O; int ldc; float* part; float* abuf;
    __device__ __forceinline__ void operator()(const f32x4 (&acc)[2][2][4][2], const Unit& u, int wr, int wc, int fr, int fq) const {
        const int row0 = u.pm * BM + wr * 64 + fr;
        if (ACT == 0 && u.pn >= a_pn) {
            if (wc == 0 && fq < 2) {
#pragma unroll
                for (int ai = 0; ai < 2; ++ai)
#pragma unroll
                    for (int m = 0; m < 4; ++m) { float* rp = abuf + (size_t)(row0 + ai * HALF + m * 16) * 16 + 8 * fq;
#pragma unroll
                        for (int n = 0; n < 2; ++n) *(f32x4*)(rp + 4 * n) = acc[ai][0][m][n]; }
            }
            return;
        }
        const int col0 = u.pn * BM + wc * 32 + 8 * fq;
        float cs[2][2][4];
#pragma unroll
        for (int bj = 0; bj < 2; ++bj)
#pragma unroll
            for (int n = 0; n < 2; ++n)
#pragma unroll
                for (int e = 0; e < 4; ++e) cs[bj][n][e] = 0.f;
#pragma unroll
        for (int ai = 0; ai < 2; ++ai)
#pragma unroll
            for (int m = 0; m < 4; ++m) { const int row = row0 + ai * HALF + m * 16; const unsigned roff = BLK ? (unsigned)((row >> 6) * sr * 4096 + (row & 63) * 64) : (unsigned)row * (unsigned)ldc + (unsigned)col0;
#pragma unroll
                for (int bj = 0; bj < 2; ++bj) { f32x4 v0 = acc[ai][bj][m][0], v1 = acc[ai][bj][m][1];
                    if (ACT == 1) { f32x2 a = gelu_pk((f32x2){v0[0], v0[1]}), b = gelu_pk((f32x2){v0[2], v0[3]}), c = gelu_pk((f32x2){v1[0], v1[1]}), d = gelu_pk((f32x2){v1[2], v1[3]});
                        v0 = (f32x4){a.x, a.y, b.x, b.y}; v1 = (f32x4){c.x, c.y, d.x, d.y}; }
                    else if (ACT == 2) {
#pragma unroll
                        for (int e = 0; e < 4; ++e) { float a = fmaxf(v0[e], 0.f), b = fmaxf(v1[e], 0.f); v0[e] = a * a; v1[e] = b * b; } }
                    if (COLSUM && part) {
#pragma unroll
                        for (int e = 0; e < 4; ++e) { cs[bj][0][e] += v0[e] * v0[e]; cs[bj][1][e] += v1[e] * v1[e]; } }
                    u32x4 w; w.x = cvt_pk_bf16(v0[0], v0[1]); w.y = cvt_pk_bf16(v0[2], v0[3]); w.z = cvt_pk_bf16(v1[0], v1[1]); w.w = cvt_pk_bf16(v1[2], v1[3]);
                    if (BLK) { const int col = col0 + bj * HALF; *(u32x4*)(O + (roff + (unsigned)((col >> 6) * sc * 4096 + (col & 63)))) = w; } else *(u32x4*)(O + (roff + bj * HALF)) = w; }
                asm volatile("" ::: "memory"); }
        if (COLSUM && part) {
#pragma unroll
            for (int bj = 0; bj < 2; ++bj)
#pragma unroll
                for (int n = 0; n < 2; ++n)
#pragma unroll
                    for (int e = 0; e < 4; ++e) { float s = cs[bj][n][e];
                        { const int ln = fq * 16 + fr; s += __builtin_bit_cast(float, __builtin_amdgcn_ds_bpermute((ln ^ 1) << 2, __builtin_bit_cast(int, s))); s += __builtin_bit_cast(float, __builtin_amdgcn_ds_bpermute((ln ^ 2) << 2, __builtin_bit_cast(int, s))); s += __builtin_bit_cast(float, __builtin_amdgcn_ds_bpermute((ln ^ 4) << 2, __builtin_bit_cast(int, s))); s += __builtin_bit_cast(float, __builtin_amdgcn_ds_bpermute((ln ^ 8) << 2, __builtin_bit_cast(int, s))); }
                        if (fr == 0) part[(size_t)(col0 + bj * HALF + 4 * n + e) * 24 + u.pm * 2 + wr] = s; }
        }
    }
};
struct EpiResid {
    static constexpr bool PERM = false, AFTER_DRAIN = false;
    const float* xin; float* xout; const float* gate;
    __device__ __forceinline__ void operator()(const f32x4 (&acc)[2][2][4][2], const Unit& u, int wr, int wc, int fr, int fq) const {
        const int row0 = u.pm * BM + wr * 64 + fr, col0 = u.pn * BM + wc * 32 + 4 * fq;
        const float* gp = gate + (size_t)(u.pm >> 5) * 6144 + col0;
#pragma unroll
        for (int bj = 0; bj < 2; ++bj)
#pragma unroll
            for (int n = 0; n < 2; ++n) { const f32x4 gv = *(const f32x4*)(gp + bj * HALF + n * 16);
#pragma unroll
                for (int ai = 0; ai < 2; ++ai)
#pragma unroll
                    for (int m = 0; m < 4; ++m) { const unsigned off = (unsigned)((row0 + ai * HALF + m * 16) * 1024 + col0 + bj * HALF + n * 16);
                        const f32x4 xi = *(const f32x4*)(xin + off); st16_wt(xout, off * 4u, __builtin_bit_cast(u32x4, xi + gv * acc[ai][bj][m][n]));
                        if (m == 3 && ai == 1 && n == 1) asm volatile("" ::: "memory"); } }
    }
};

__device__ __forceinline__ const char* uni(const char* p) { const unsigned long long v = (unsigned long long)p;
    const unsigned lo = __builtin_amdgcn_readfirstlane((unsigned)v), hi = __builtin_amdgcn_readfirstlane((unsigned)(v >> 32)); return (const char*)(((unsigned long long)hi << 32) | lo); }
template <class Epi, class Sched, bool ALIGN_EPI = false, bool SP2 = false>
__device__ __forceinline__ void gemm_phase(const int tid, LAS unsigned char* lds, const Gemm g, const Sched& S, const Epi& E) {
    const int wid = __builtin_amdgcn_readfirstlane(tid >> 6), lane = tid & 63, wr = wid >> 2, wc = wid & 3, fr = lane & 15, fq = lane >> 4;
    const int K = g.K, nt = K / BK;
    unsigned voffA[2], voffB[2];
#pragma unroll
    for (int i = 0; i < 2; ++i) { int R, C; stage_rc(tid * 16 + i * 8192, R, C); const int Rb = Epi::PERM ? ((R & ~31) + perm32(R & 31)) : R;
        voffA[i] = (unsigned)(R * K + C) * 2u; voffB[i] = (unsigned)(Rb * K + C) * 2u; }
    const size_t kstep = (size_t)(BK * 2);
    const size_t hstep = (size_t)HALF * K * 2;
    const size_t tstep = 2 * hstep;
    const unsigned ldsw = (unsigned)wid * 1024u;
    const int aoff = lds_byte(wr * 64 + fr, fq * 8), boff = lds_byte(wc * 32 + fr, fq * 8);
#define PG8_SA(b, h) (((b) * 2 + (h)) * HTB)
#define PG8_SB(b, h) ((4 + (b) * 2 + (h)) * HTB)
#define PG8_STAGE(bufoff, gbase, voff) do { _Pragma("unroll") for (int _i = 0; _i < 2; ++_i) \
        __builtin_amdgcn_global_load_lds((const unsigned*)((const char*)(gbase) + (voff)[_i]), (LAS unsigned*)(lds + (bufoff) + ldsw + _i * 8192), 16, 0, 0); } while (0)
#define PG8_LDA(dst, b, h) do { _Pragma("unroll") for (int m = 0; m < 4; ++m) _Pragma("unroll") for (int k = 0; k < 2; ++k) dst[m][k] = *(const LAS bf16x8*)(lds + PG8_SA(b, h) + aoff + m * 2048 + k * 1024); } while (0)
#define PG8_LDB(dst, b, h) do { _Pragma("unroll") for (int n = 0; n < 2; ++n) _Pragma("unroll") for (int k = 0; k < 2; ++k) dst[n][k] = *(const LAS bf16x8*)(lds + PG8_SB(b, h) + boff + n * 2048 + k * 1024); } while (0)
#define PG8_MMA(ai, bj, At, Bt) do { __builtin_amdgcn_s_setprio(1); _Pragma("unroll") for (int m = 0; m < 4; ++m) _Pragma("unroll") for (int n = 0; n < 2; ++n) _Pragma("unroll") for (int k = 0; k < 2; ++k) \
        acc[ai][bj][m][n] = __builtin_amdgcn_mfma_f32_16x16x32_bf16(Bt[n][k], At[m][k], acc[ai][bj][m][n], 0, 0, 0); __builtin_amdgcn_s_setprio(0); } while (0)
#define PG8_WAIT_V(n) asm volatile("s_waitcnt vmcnt(" #n ")" ::: "memory")
#define PG8_WAIT_L(n) asm volatile("s_waitcnt lgkmcnt(" #n ")" ::: "memory")
#define PG8_BAR __builtin_amdgcn_s_barrier()
#define PG8_SCHED __builtin_amdgcn_sched_barrier(0)
    Unit cur, nxt; int ui = 0;
    if (!S.next(0, cur)) return;
    f32x4 acc[2][2][4][2];
#pragma unroll
    for (int a = 0; a < 2; ++a)
#pragma unroll
        for (int b = 0; b < 2; ++b)
#pragma unroll
            for (int m = 0; m < 4; ++m)
#pragma unroll
                for (int n = 0; n < 2; ++n) acc[a][b][m][n] = (f32x4){0.f, 0.f, 0.f, 0.f};
    bf16x8 At[4][2], B0[2][2], B1[2][2];
    const char* cA = uni((const char*)g.A + (size_t)cur.pm * tstep); const char* cB = uni((const char*)g.Bt + (size_t)cur.pn * tstep);
    S.a_ready(cur);
    if constexpr (SP2) {
        PG8_STAGE(PG8_SB(0, 0), cB, voffB); PG8_STAGE(PG8_SB(0, 1), cB + hstep, voffB); PG8_STAGE(PG8_SA(0, 0), cA, voffA); PG8_STAGE(PG8_SA(0, 1), cA + hstep, voffA);
        if (wr == 1) PG8_BAR;
        PG8_WAIT_V(2); PG8_BAR;
        PG8_STAGE(PG8_SB(1, 0), cB + kstep, voffB); PG8_STAGE(PG8_SA(1, 0), cA + kstep, voffA); PG8_STAGE(PG8_SB(1, 1), cB + hstep + kstep, voffB);
        PG8_WAIT_V(6); PG8_BAR;
    } else {
        PG8_STAGE(PG8_SB(0, 0), cB, voffB); PG8_STAGE(PG8_SA(0, 0), cA, voffA); PG8_STAGE(PG8_SB(0, 1), cB + hstep, voffB); PG8_STAGE(PG8_SA(0, 1), cA + hstep, voffA);
        if (wr == 1) PG8_BAR;
        PG8_WAIT_V(4); PG8_BAR;
        PG8_STAGE(PG8_SB(1, 0), cB + kstep, voffB); PG8_STAGE(PG8_SA(1, 0), cA + kstep, voffA); PG8_STAGE(PG8_SB(1, 1), cB + hstep + kstep, voffB);
        PG8_WAIT_V(6); PG8_BAR;
    }
    for (;;) {
        const bool has_next = S.next(ui + 1, nxt);
        const char* nA = uni(has_next ? (const char*)g.A + (size_t)nxt.pm * tstep : cA); const char* nB = uni(has_next ? (const char*)g.Bt + (size_t)nxt.pn * tstep : cB);
        for (int t = 0; t < nt; t += 2) {
            const bool last = (t == nt - 2);
            const char* a1 = uni(cA + (size_t)(t + 1) * kstep);
            const char* a2 = uni(last ? nA : cA + (size_t)(t + 2) * kstep); const char* b2 = uni(last ? nB : cB + (size_t)(t + 2) * kstep);
            const char* a3 = a2 + kstep; const char* b3 = b2 + kstep;
            if (last && has_next) S.a_ready(nxt);
            if constexpr (SP2) {
            PG8_LDB(B0, 0, 0); PG8_LDB(B1, 0, 1); PG8_SCHED; PG8_LDA(At, 0, 0); PG8_STAGE(PG8_SA(1, 1), a1 + hstep, voffA);
            PG8_WAIT_V(8); PG8_WAIT_L(0); PG8_BAR; PG8_MMA(0, 0, At, B0); PG8_MMA(0, 1, At, B1); PG8_BAR; PG8_SCHED;
            PG8_LDA(At, 0, 1); PG8_STAGE(PG8_SB(0, 0), b2, voffB); PG8_STAGE(PG8_SB(0, 1), b2 + hstep, voffB); PG8_STAGE(PG8_SA(0, 0), a2, voffA);
            PG8_WAIT_V(8); PG8_WAIT_L(0); PG8_BAR; PG8_MMA(1, 0, At, B0); PG8_MMA(1, 1, At, B1); PG8_BAR; PG8_SCHED;
            PG8_LDB(B0, 1, 0); PG8_LDB(B1, 1, 1); PG8_SCHED; PG8_LDA(At, 1, 0); PG8_STAGE(PG8_SA(0, 1), a2 + hstep, voffA);
            PG8_WAIT_V(8); PG8_WAIT_L(0); PG8_BAR; PG8_MMA(0, 0, At, B0); PG8_MMA(0, 1, At, B1); PG8_BAR; PG8_SCHED;
            PG8_LDA(At, 1, 1); PG8_STAGE(PG8_SB(1, 0), b3, voffB); PG8_STAGE(PG8_SB(1, 1), b3 + hstep, voffB); PG8_STAGE(PG8_SA(1, 0), a3, voffA);
            PG8_WAIT_V(8); PG8_WAIT_L(0); PG8_BAR; PG8_MMA(1, 0, At, B0); PG8_MMA(1, 1, At, B1); PG8_BAR; PG8_SCHED;
            } else {
            PG8_LDB(B0, 0, 0); PG8_SCHED; PG8_LDA(At, 0, 0); PG8_STAGE(PG8_SA(1, 1), a1 + hstep, voffA);
            PG8_WAIT_L(8); PG8_BAR; PG8_WAIT_L(0); PG8_MMA(0, 0, At, B0); PG8_BAR; PG8_SCHED;
            PG8_LDB(B1, 0, 1); PG8_STAGE(PG8_SB(0, 0), b2, voffB);
            PG8_BAR; PG8_WAIT_L(0); PG8_MMA(0, 1, At, B1); PG8_BAR;
            PG8_LDA(At, 0, 1); PG8_STAGE(PG8_SA(0, 0), a2, voffA);
            PG8_BAR; PG8_WAIT_L(0); PG8_MMA(1, 0, At, B0); PG8_BAR; PG8_SCHED;
            PG8_STAGE(PG8_SB(0, 1), b2 + hstep, voffB);
            PG8_WAIT_V(6); PG8_BAR; PG8_MMA(1, 1, At, B1); PG8_BAR;
            PG8_LDB(B0, 1, 0); PG8_SCHED; PG8_LDA(At, 1, 0); PG8_STAGE(PG8_SA(0, 1), a2 + hstep, voffA);
            PG8_WAIT_L(8); PG8_BAR; PG8_WAIT_L(0); PG8_MMA(0, 0, At, B0); PG8_BAR; PG8_SCHED;
            PG8_LDB(B1, 1, 1); PG8_STAGE(PG8_SB(1, 0), b3, voffB);
            PG8_BAR; PG8_WAIT_L(0); PG8_MMA(0, 1, At, B1); PG8_BAR;
            PG8_LDA(At, 1, 1); PG8_STAGE(PG8_SA(1, 0), a3, voffA);
            PG8_BAR; PG8_WAIT_L(0); PG8_MMA(1, 0, At, B0); PG8_BAR; PG8_SCHED;
            PG8_STAGE(PG8_SB(1, 1), b3 + hstep, voffB);
            PG8_WAIT_V(6); PG8_BAR; PG8_MMA(1, 1, At, B1); PG8_BAR;
            }
        }
        if constexpr (ALIGN_EPI) { if (wr == 0) PG8_BAR; }
        { int fr_e = fr, fq_e = fq; asm volatile("" : "+v"(fr_e), "+v"(fq_e));
          E(acc, cur, wr, wc, fr_e, fq_e); } S.done(cur);
        if (!has_next) break;
#pragma unroll
        for (int a = 0; a < 2; ++a)
#pragma unroll
            for (int b = 0; b < 2; ++b)
#pragma unroll
                for (int m = 0; m < 4; ++m)
#pragma unroll
                    for (int n = 0; n < 2; ++n) acc[a][b][m][n] = (f32x4){0.f, 0.f, 0.f, 0.f};
        cur = nxt; cA = nA; cB = nB; ++ui;
        if constexpr (ALIGN_EPI) { if (wr == 1) PG8_BAR; }
    }
    PG8_WAIT_V(0);
    if constexpr (!ALIGN_EPI) { if (wr == 0) PG8_BAR; }
    PG8_BAR;
#undef PG8_SA
#undef PG8_SB
#undef PG8_STAGE
#undef PG8_LDA
#undef PG8_LDB
#undef PG8_MMA
#undef PG8_WAIT_V
#undef PG8_WAIT_L
#undef PG8_BAR
#undef PG8_SCHED
}
}

constexpr int NTOK = 32768, DM = 1024, SEQ = 8192;
constexpr float EPS = 1e-6f;
constexpr size_t MiB = (size_t)1 << 20;
constexpr size_t OFF_MOD = 0;
constexpr size_t OFF_BAR = 512 * 1024;
constexpr size_t OFF_PART = 1 * MiB;
constexpr size_t OFF_ABUF = 1 * MiB;
constexpr size_t OFF_DBUF = 3 * MiB;
constexpr size_t OFF_W = 4 * MiB;
constexpr size_t OFF_H = 111 * MiB;
constexpr size_t OFF_BIG = 175 * MiB;
constexpr size_t WS_NEED = 511 * MiB;
constexpr size_t WA_IN = 0, WA_OUT = 3145728, WB_IN = 4194304, WB_OUT = 10485760, WC_IN = 13631488, WC_OUT = 17039360, WD_IN = 18087936, WD_OUT = 21233664, W_F1 = 22282240, W_F2 = 39059456, W_END = 55836672;
static_assert(OFF_W + W_END * 2 <= OFF_H, "weights overflow");
constexpr size_t B_QK = 0, B_VT = 128 * MiB;
constexpr size_t B_U = 0, B_VTB = 192 * MiB;
constexpr size_t B_DS = 192 * MiB, B_ATT = 320 * MiB;
constexpr size_t B_HID = 0;

constexpr int NSEG = 19;
struct SegTab { int v[NSEG][9]; int nitems; };
constexpr SegTab make_segs() {
    SegTab r{}; int n = 0, items = 0;
    auto add = [&](int in_idx, long src_off, int K, int ldw, int nsrc0, int ncols, long dst_off, int row_off) {
        r.v[n][0] = in_idx; r.v[n][1] = (int)src_off; r.v[n][2] = (int)dst_off; r.v[n][3] = K; r.v[n][4] = ldw; r.v[n][5] = nsrc0; r.v[n][6] = ncols; r.v[n][7] = row_off; r.v[n][8] = items; ++n;
        items += (K / 64) * ((ncols + 31) / 32); };
    add(8, 0, 1024, 3072, 0, 3072, WA_IN, 0);
    add(12, 0, 1024, 1024, 0, 1024, WA_OUT, 0);
    add(13, 0, 1024, 6144, 0, 6144, WB_IN, 0);
    add(17, 0, 3072, 1024, 0, 1024, WB_OUT, 0);
    add(18, 0, 1024, 3088, 0, 1024, WC_IN, 0);
    add(18, 0, 1024, 3088, 2048, 1024, WC_IN, 1024);
    add(18, 0, 1024, 3088, 3072, 16, WC_IN, 2048);
    add(18, 0, 1024, 3088, 1024, 1024, WC_IN, 2304);
    add(22, 0, 1024, 1024, 0, 1024, WC_OUT, 0);
    add(23, 0, 1024, 3072, 0, 3072, WD_IN, 0);
    add(24, 0, 1024, 1024, 0, 1024, WD_OUT, 0);
    for (int l = 0; l < 4; ++l) add(6, (long)l * 4194304, 1024, 4096, 0, 4096, (long)W_F1 + (long)l * 4194304, 0);
    for (int l = 0; l < 4; ++l) add(7, (long)l * 4194304, 4096, 1024, 0, 1024, (long)W_F2 + (long)l * 4194304, 0);
    r.nitems = items; return r;
}
constexpr int NITEMS = make_segs().nitems;
struct Params {
    const float* in[25];
    float* out; unsigned char* ws;
    int ph_lo, ph_hi;
};

#ifndef DBL_MASK
#define DBL_MASK 0
#endif
constexpr int NBASE = 39;
struct PhTab { unsigned char t[2 * NBASE + 64][4]; int n; };
constexpr PhTab make_tab() {
    const unsigned char base[NBASE][4] = {
        {0, 0, 0, 0},
        {1, 0, 0, 0}, {2, 0, 0, 1}, {12, 0, 0, 0}, {17, 0, 0, 0}, {4, 0, 0, 0}, {3, 0, 0, 0}, {1, 0, 1, 0}, {10, 0, 1, 0}, {16, 0, 1, 0},
        {1, 1, 0, 0}, {11, 1, 0, 1}, {14, 1, 0, 0}, {5, 1, 0, 0}, {11, 1, 1, 1}, {14, 1, 1, 0}, {5, 1, 1, 0}, {15, 1, 0, 0}, {1, 1, 1, 0}, {10, 1, 1, 0}, {16, 1, 1, 0},
        {1, 2, 0, 0}, {13, 2, 0, 1}, {12, 2, 2, 0}, {6, 2, 0, 0}, {7, 2, 0, 0}, {8, 2, 0, 0}, {3, 2, 0, 0}, {1, 2, 1, 0}, {10, 2, 1, 0}, {16, 2, 1, 0},
        {1, 3, 0, 0}, {2, 3, 0, 1}, {12, 3, 1, 0}, {9, 3, 0, 0}, {3, 3, 0, 0}, {1, 3, 1, 0}, {10, 3, 1, 0}, {16, 3, 1, 0}};
    PhTab r{}; int n = 0;
    for (int i = 0; i < NBASE; ++i) { const int reps = ((DBL_MASK >> base[i][0]) & 1) ? 2 : 1;
        for (int k = 0; k < reps; ++k) { r.t[n][0] = base[i][0]; r.t[n][1] = base[i][1]; r.t[n][2] = base[i][2]; r.t[n][3] = (unsigned char)(((i <= 6) ? 1 : 0) | ((base[i][3] && k == reps - 1) ? 2 : 0)); ++n; } }
#ifdef EXTRA_SYNCS
    for (int k = 0; k < EXTRA_SYNCS; ++k) { r.t[n][0] = 1; r.t[n][1] = 0; r.t[n][2] = 2; r.t[n][3] = 0; ++n; }
#endif
    r.n = n; return r;
}
constexpr int NPHASE = make_tab().n;
__constant__ PhTab PHT = make_tab();

__device__ __forceinline__ unsigned f2bf(float f) { unsigned u = __builtin_bit_cast(unsigned, f); return (u + 0x7fffu + ((u >> 16) & 1u)) >> 16; }
__device__ __forceinline__ unsigned pk2(float lo, float hi) { return f2bf(lo) | (f2bf(hi) << 16); }
__device__ __forceinline__ float bf2f(unsigned short s) { return __uint_as_float(((unsigned)s) << 16); }
__device__ __forceinline__ bf16x8 ldg8(const bf16_t* p) { return *(const bf16x8*)p; }
__device__ __forceinline__ void unpack8(bf16x8 v, float* f) { const u32x4 u = __builtin_bit_cast(u32x4, v);
#pragma unroll
    for (int i = 0; i < 4; ++i) { f[2 * i] = __uint_as_float(u[i] << 16); f[2 * i + 1] = __uint_as_float(u[i] & 0xffff0000u); } }
__device__ __forceinline__ bf16x8 pack8(const float* f) { u32x4 u;
#pragma unroll
    for (int i = 0; i < 4; ++i) u[i] = pg8::cvt_pk_bf16(f[2 * i], f[2 * i + 1]);
    return __builtin_bit_cast(bf16x8, u); }
__device__ __forceinline__ void unpack4(u32x2 u, float* f) { f[0] = __uint_as_float(u.x << 16); f[1] = __uint_as_float(u.x & 0xffff0000u); f[2] = __uint_as_float(u.y << 16); f[3] = __uint_as_float(u.y & 0xffff0000u); }
__device__ __forceinline__ u32x2 pack4(float a, float b, float c, float d) { u32x2 r; r.x = pg8::cvt_pk_bf16(a, b); r.y = pg8::cvt_pk_bf16(c, d); return r; }
__device__ __forceinline__ f32x4 mfma16(bf16x8 a, bf16x8 b, f32x4 c) { return __builtin_amdgcn_mfma_f32_16x16x32_bf16(a, b, c, 0, 0, 0); }
__device__ __forceinline__ float shx(float v, int lane, int mask) { return __builtin_bit_cast(float, __builtin_amdgcn_ds_bpermute((lane ^ mask) << 2, __builtin_bit_cast(int, v))); }

#define LDS_WAIT() asm volatile("s_waitcnt lgkmcnt(0)" ::: "memory")
#define SB0() __builtin_amdgcn_sched_barrier(0)
#define GAS __attribute__((address_space(1)))
#define CAS __attribute__((address_space(4)))
template <class T> __device__ __forceinline__ T* as_global(T* p) { return (T*)(GAS T*)p; }

struct ItemP { const float* src; bf16_t* dst; int K, ld, n0, nc, ro, idx; };
__device__ __forceinline__ void tr_load(const ItemP& q, int lane, float (&wv)[32]) {
    const int nblk = (q.nc + 31) >> 5, kb = q.idx / nblk, nb = q.idx - kb * nblk, k0 = 64 * kb, n0 = 32 * nb;
    const int nn = n0 + (lane & 31); const bool ok = nn < q.nc;
#pragma unroll
    for (int i = 0; i < 32; ++i) { const int kk = 2 * i + (lane >> 5); wv[i] = ok ? q.src[(size_t)(k0 + kk) * q.ld + q.n0 + nn] : 0.f; }
}
__device__ __forceinline__ void tr_store(const ItemP& q, int lane, const float (&wv)[32], LAS float* scr) {
    const int nblk = (q.nc + 31) >> 5, kb = q.idx / nblk, nb = q.idx - kb * nblk, k0 = 64 * kb, n0 = 32 * nb;
#pragma unroll
    for (int i = 0; i < 32; ++i) { const int kk = 2 * i + (lane >> 5); scr[kk * 33 + (lane & 31)] = wv[i]; }
    LDS_WAIT(); asm volatile("" ::: "memory");
    const int c = lane & 7;
#pragma unroll
    for (int j = 0; j < 4; ++j) { const int n = (lane >> 3) + 8 * j; const LAS float* sp = scr + (8 * c) * 33 + n;
        u32x4 o; o.x = pk2(sp[0 * 33], sp[1 * 33]); o.y = pk2(sp[2 * 33], sp[3 * 33]); o.z = pk2(sp[4 * 33], sp[5 * 33]); o.w = pk2(sp[6 * 33], sp[7 * 33]);
        *(u32x4*)(q.dst + (size_t)(q.ro + n0 + n) * q.K + k0 + 8 * c) = o; }
    LDS_WAIT(); asm volatile("" ::: "memory");
}
__device__ __forceinline__ ItemP tr_decode(int it, const CAS Params* pp, unsigned char* ws) {
    constexpr SegTab ST = make_segs();
    int sidx = ST.v[0][0], ssrc = ST.v[0][1], sdst = ST.v[0][2], sK = ST.v[0][3], sld = ST.v[0][4], sn0 = ST.v[0][5], snc = ST.v[0][6], sro = ST.v[0][7], si0 = 0;
#pragma unroll
    for (int q = 1; q < NSEG; ++q) { const bool t = it >= ST.v[q][8];
        sidx = t ? ST.v[q][0] : sidx; ssrc = t ? ST.v[q][1] : ssrc; sdst = t ? ST.v[q][2] : sdst; sK = t ? ST.v[q][3] : sK; sld = t ? ST.v[q][4] : sld; sn0 = t ? ST.v[q][5] : sn0; snc = t ? ST.v[q][6] : snc; sro = t ? ST.v[q][7] : sro; si0 = t ? ST.v[q][8] : si0; }
    const float* src = pp->in[6];
    src = sidx == 7 ? pp->in[7] : src; src = sidx == 8 ? pp->in[8] : src; src = sidx == 12 ? pp->in[12] : src; src = sidx == 13 ? pp->in[13] : src; src = sidx == 17 ? pp->in[17] : src;
    src = sidx == 18 ? pp->in[18] : src; src = sidx == 22 ? pp->in[22] : src; src = sidx == 23 ? pp->in[23] : src; src = sidx == 24 ? pp->in[24] : src;
    ItemP r; r.src = as_global(src) + (size_t)(unsigned)ssrc; r.dst = (bf16_t*)(ws + OFF_W) + (size_t)(unsigned)sdst; r.K = sK; r.ld = sld; r.n0 = sn0; r.nc = snc; r.ro = sro; r.idx = it - si0;
    return r;
}
__device__ __forceinline__ void p0_phase(const int tid, const int bid, const CAS Params* pp, unsigned char* ws, LAS unsigned char* lds) {
    const int lane = tid & 63, wave = __builtin_amdgcn_readfirstlane(tid >> 6), G = gridDim.x;
    float* mod = (float*)(ws + OFF_MOD);
    const float* cin = as_global(pp->in[1]); const float* ada_w = as_global(pp->in[2]); const float* ada_b = as_global(pp->in[3]);
    for (int item = bid; item < 256; item += G) {
        const int L = item >> 6, cgp = item & 63, c4 = lane % 24, kq = lane / 24, k0 = wave * 128;
        f32x4 a0 = {0.f, 0.f, 0.f, 0.f}, a1 = a0, a2 = a0, a3 = a0;
        if (kq < 2) {
            const float* wp = ada_w + ((size_t)L * 1024 + k0 + kq) * 6144 + cgp * 96 + 4 * c4;
#pragma unroll 8
            for (int k = 0; k < 64; ++k) {
                const f32x4 w4 = *(const f32x4*)(wp + (size_t)(2 * k) * 6144);
                const int kk = k0 + kq + 2 * k;
                const float c0 = cin[kk], c1 = cin[1024 + kk], c2 = cin[2048 + kk], c3 = cin[3072 + kk];
                a0 += w4 * (c0 / (1.f + __expf(-c0))); a1 += w4 * (c1 / (1.f + __expf(-c1))); a2 += w4 * (c2 / (1.f + __expf(-c2))); a3 += w4 * (c3 / (1.f + __expf(-c3)));
            }
        }
        LAS float* red = (LAS float*)lds;
        if (kq < 2) { const int kg = wave * 2 + kq;
            *(LAS f32x4*)(red + (kg * 4 + 0) * 96 + 4 * c4) = a0; *(LAS f32x4*)(red + (kg * 4 + 1) * 96 + 4 * c4) = a1;
            *(LAS f32x4*)(red + (kg * 4 + 2) * 96 + 4 * c4) = a2; *(LAS f32x4*)(red + (kg * 4 + 3) * 96 + 4 * c4) = a3; }
        __syncthreads();
        if (tid < 384) { const int b = tid / 96, cc = tid - b * 96; float s = ada_b[L * 6144 + cgp * 96 + cc];
#pragma unroll
            for (int w = 0; w < 16; ++w) s += red[(w * 4 + b) * 96 + cc];
            mod[(size_t)(L * 4 + b) * 6144 + cgp * 96 + cc] = s; }
        __syncthreads();
    }
    LAS float* scr = (LAS float*)(lds + wave * 16384);
    const int gw = bid * 8 + wave, NGW = G * 8;
    for (int it = gw; it < NITEMS; it += 2 * NGW) {
        const int it2 = it + NGW; const bool has2 = it2 < NITEMS;
        const ItemP qa = tr_decode(it, pp, ws), qb = tr_decode(has2 ? it2 : it, pp, ws);
        float wa[32], wb[32];
        tr_load(qa, lane, wa); tr_load(qb, lane, wb);
        SB0();
        tr_store(qa, lane, wa, scr);
        if (has2) tr_store(qb, lane, wb, scr);
    }
}

__device__ __forceinline__ void norm_phase(const int tid, const int bid, const float* x, const float* gain, const float* sh, const float* sc, bf16_t* H) {
    const int lane = tid & 63, wave = __builtin_amdgcn_readfirstlane(tid >> 6);
    const int gw = bid * 8 + wave, NGW = gridDim.x * 8;
    for (int row0 = gw * 4; row0 < NTOK; row0 += NGW * 4) {
        const int b = row0 >> 13;
        f32x4 v[4][4];
#pragma unroll
        for (int r = 0; r < 4; ++r)
#pragma unroll
            for (int j = 0; j < 4; ++j) v[r][j] = *((const f32x4*)(x + (size_t)(row0 + r) * DM) + lane + 64 * j);
        f32x4 gm[4], hh[4];
#pragma unroll
        for (int j = 0; j < 4; ++j) { const f32x4 gn = *((const f32x4*)gain + lane + 64 * j), s4 = *((const f32x4*)(sc + (size_t)b * 6144) + lane + 64 * j); gm[j] = gn * (s4 + 1.f); hh[j] = *((const f32x4*)(sh + (size_t)b * 6144) + lane + 64 * j); }
        SB0();
        float ss[4];
#pragma unroll
        for (int r = 0; r < 4; ++r) { float s = 0.f;
#pragma unroll
            for (int j = 0; j < 4; ++j) s += (v[r][j].x * v[r][j].x + v[r][j].y * v[r][j].y) + (v[r][j].z * v[r][j].z + v[r][j].w * v[r][j].w);
            ss[r] = s; }
#pragma unroll
        for (int o = 1; o < 64; o <<= 1) {
#pragma unroll
            for (int r = 0; r < 4; ++r) ss[r] += shx(ss[r], lane, o); }
#pragma unroll
        for (int r = 0; r < 4; ++r) { const float rr = rsqrtf(ss[r] * (1.f / DM) + EPS);
            u32x2* o8 = (u32x2*)(H + (size_t)(row0 + r) * DM) + lane;
#pragma unroll
            for (int j = 0; j < 4; ++j) { const f32x4 y = v[r][j] * rr * gm[j] + hh[j]; o8[64 * j] = pack4(y.x, y.y, y.z, y.w); } }
    }
}

__device__ __forceinline__ void qknorm_phase(const int tid, const int bid, bf16_t* QK, const float* qgain, const float* kgain) {
    const int lane = tid & 63, wave = __builtin_amdgcn_readfirstlane(tid >> 6), sub = lane >> 3, c8 = lane & 7;
    const int gw = bid * 8 + wave, NGW = gridDim.x * 8;
    float qg[8], kg[8];
#pragma unroll
    for (int x = 0; x < 8; ++x) { qg[x] = qgain[8 * c8 + x] * (0.125f * 1.4426950408889634f)  ; kg[x] = kgain[8 * c8 + x]; }
    for (int it = gw; it < 32768; it += NGW) {
        bf16x8 v[4];
#pragma unroll
        for (int u = 0; u < 4; ++u) v[u] = ldg8(QK + ((size_t)it * 32 + u * 8 + sub) * 64 + 8 * c8);
#pragma unroll
        for (int u = 0; u < 4; ++u) { float f[8]; unpack8(v[u], f); float ss = 0.f;
#pragma unroll
            for (int x = 0; x < 8; ++x) ss += f[x] * f[x];
            ss += shx(ss, lane, 1); ss += shx(ss, lane, 2); ss += shx(ss, lane, 4);
            const float r = rsqrtf(ss * (1.f / 64.f) + EPS); const bool isq = it < 16384;
#pragma unroll
            for (int x = 0; x < 8; ++x) f[x] *= r * (isq ? qg[x] : kg[x]);
            *(bf16x8*)(QK + ((size_t)it * 32 + u * 8 + sub) * 64 + 8 * c8) = pack8(f); }
    }
}
__device__ __forceinline__ void load_kfrag(bf16x8 (&kf)[8], const bf16_t* kbase  ) {
#pragma unroll
    for (int c2 = 0; c2 < 2; ++c2)
#pragma unroll
        for (int e = 0; e < 2; ++e) { const bf16_t* kp = kbase + (32 * c2 + 4 * e) * 64; kf[(c2 * 2 + e) * 2] = ldg8(kp); kf[(c2 * 2 + e) * 2 + 1] = ldg8(kp + 32); }
}
__device__ __forceinline__ void load_vfrag(bf16x8 (&vf)[8], const bf16_t* vbase  ) {
#pragma unroll
    for (int c2 = 0; c2 < 2; ++c2)
#pragma unroll
        for (int dt = 0; dt < 4; ++dt) vf[c2 * 4 + dt] = ldg8(vbase + dt * 16 * 64 + 32 * c2);
}
__device__ __forceinline__ void attn_a_phase(const int tid, const int bid, LAS unsigned char* lds, const bf16_t* QK, const bf16_t* VT, bf16_t* O, const float* relb) {
    const int lane = tid & 63, wave = __builtin_amdgcn_readfirstlane(tid >> 6), j = lane & 15, g = lane >> 4;
    const int gw = bid * 8 + wave, NGW = gridDim.x * 8;
    const int klane = (8 * (j >> 2) + (j & 3)) * 64 + 8 * g, vlane = j * 64 + 8 * g;
    for (int id = gw; id < 16384; id += NGW) {
        const int qt2 = id & 1, h = (id >> 1) & 15, ci = (id >> 5) & 127, b = id >> 12;
        const int tq0 = ci * 64 + qt2 * 32 + j;
        const size_t tokq = (size_t)b * SEQ + tq0;
        bf16x8 qb[2][2];
        { const bf16_t* qp = QK + ((size_t)(h * 512) + (tokq >> 6)) * 4096 + (tokq & 63) * 64 + 8 * g; qb[0][0] = ldg8(qp); qb[0][1] = ldg8(qp + 32); qb[1][0] = ldg8(qp + 16 * 64); qb[1][1] = ldg8(qp + 16 * 64 + 32); }
        float m_run[2] = {-INFINITY, -INFINITY}, l_run[2] = {0.f, 0.f};
        f32x4 o[2][4];
#pragma unroll
        for (int qs = 0; qs < 2; ++qs)
#pragma unroll
            for (int dt = 0; dt < 4; ++dt) o[qs][dt] = (f32x4){0.f, 0.f, 0.f, 0.f};
        LAS float* tb = (LAS float*)(lds + wave * 2048);
#pragma unroll
        for (int i = 0; i < 5; ++i) tb[lane + 64 * i] = relb[h * 320 + lane + 64 * i] * 1.4426950408889634f;
        const float bc = relb[h * 320 + 319] * 1.4426950408889634f;
        const int kt_lo = ci > 8 ? ci - 8 : 0;
        const bf16_t* kblk = QK + ((size_t)((16 + h) * 512) + b * 128) * 4096 + klane;
        const bf16_t* vblk = VT + ((size_t)(h * 512) + b * 128) * 4096 + vlane;
        bf16x8 kf[8]; load_kfrag(kf, kblk + (size_t)kt_lo * 4096);
        asm volatile("" :: "v"(kf[0]), "v"(kf[1]), "v"(kf[2]), "v"(kf[3]), "v"(kf[4]), "v"(kf[5]), "v"(kf[6]), "v"(kf[7]));
        for (int kt = kt_lo; kt <= ci; ++kt) {
            bf16x8 vf[8], kn[8];
            load_vfrag(vf, vblk + (size_t)kt * 4096);
            load_kfrag(kn, kblk + (size_t)(kt < ci ? kt + 1 : kt) * 4096);
            SB0();
            f32x4 sq[2][2][2];
#pragma unroll
            for (int qs = 0; qs < 2; ++qs)
#pragma unroll
                for (int c2 = 0; c2 < 2; ++c2)
#pragma unroll
                    for (int e = 0; e < 2; ++e) { f32x4 a = mfma16(kf[(c2 * 2 + e) * 2], qb[qs][0], (f32x4){0.f, 0.f, 0.f, 0.f}); sq[qs][c2][e] = mfma16(kf[(c2 * 2 + e) * 2 + 1], qb[qs][1], a); }
            const bool cbias = (ci - kt >= 5);
#pragma unroll
            for (int qs = 0; qs < 2; ++qs) {
                float tmax = -INFINITY;
                if (!cbias) { const int i0 = tq0 + 16 * qs - (kt * 64 + 8 * g) + 63;
#pragma unroll
                    for (int c2 = 0; c2 < 2; ++c2)
#pragma unroll
                        for (int x = 0; x < 8; ++x) { const int ix = i0 - 32 * c2 - x; sq[qs][c2][x >> 2][x & 3] += tb[ix > 319 ? 319 : ix]; }
                } else {
#pragma unroll
                    for (int c2 = 0; c2 < 2; ++c2)
#pragma unroll
                        for (int x = 0; x < 8; ++x) sq[qs][c2][x >> 2][x & 3] += bc; }
#pragma unroll
                for (int c2 = 0; c2 < 2; ++c2)
#pragma unroll
                    for (int x = 0; x < 8; ++x) tmax = fmaxf(tmax, sq[qs][c2][x >> 2][x & 3]);
                tmax = fmaxf(tmax, shx(tmax, lane, 16)); tmax = fmaxf(tmax, shx(tmax, lane, 32));
                const float m_new = fmaxf(m_run[qs], tmax), alpha = __builtin_amdgcn_exp2f(m_run[qs] - m_new);
                float lsum = 0.f; float pf[2][8];
#pragma unroll
                for (int c2 = 0; c2 < 2; ++c2)
#pragma unroll
                    for (int x = 0; x < 8; ++x) { const float pv = __builtin_amdgcn_exp2f(sq[qs][c2][x >> 2][x & 3] - m_new); pf[c2][x] = pv; lsum += pv; }
                l_run[qs] = l_run[qs] * alpha + lsum; m_run[qs] = m_new;
#pragma unroll
                for (int dt = 0; dt < 4; ++dt) o[qs][dt] *= alpha;
#pragma unroll
                for (int c2 = 0; c2 < 2; ++c2) { const bf16x8 pb = pack8(pf[c2]);
#pragma unroll
                    for (int dt = 0; dt < 4; ++dt) o[qs][dt] = mfma16(vf[c2 * 4 + dt], pb, o[qs][dt]); }
            }
            SB0();
            asm volatile("" :: "v"(kn[0]), "v"(kn[1]), "v"(kn[2]), "v"(kn[3]), "v"(kn[4]), "v"(kn[5]), "v"(kn[6]), "v"(kn[7]));
#pragma unroll
            for (int x = 0; x < 8; ++x) kf[x] = kn[x];
        }
#pragma unroll
        for (int qs = 0; qs < 2; ++qs) {
            float l = l_run[qs]; l += shx(l, lane, 16); l += shx(l, lane, 32);
            const float inv = 1.f / l;
#pragma unroll
            for (int dt = 0; dt < 4; ++dt) *(u32x2*)(O + (tokq + 16 * qs) * 1024 + h * 64 + dt * 16 + 4 * g) = pack4(o[qs][dt][0] * inv, o[qs][dt][1] * inv, o[qs][dt][2] * inv, o[qs][dt][3] * inv);
        }
    }
}

__device__ __forceinline__ void attn_d_phase(const int tid, const int bid, const bf16_t* QK, const bf16_t* VT, bf16_t* O) {
    const int lane = tid & 63, wave = __builtin_amdgcn_readfirstlane(tid >> 6), j = lane & 15, g = lane >> 4;
    const int gw = bid * 8 + wave, NGW = gridDim.x * 8;
    const int klane = (8 * (j >> 2) + (j & 3)) * 64 + 8 * g, vlane = j * 64 + 8 * g;
    for (int id = gw; id < 16384; id += NGW) {
        const int qt32 = id & 255, h = (id >> 8) & 15, b = id >> 12;
        const int tq0 = qt32 * 32 + j;
        const size_t tokq = (size_t)b * SEQ + tq0;
        const bf16_t* qp = QK + ((size_t)(h * 512) + (tokq >> 6)) * 4096 + (tokq & 63) * 64 + 8 * g;
        bf16x8 qb[2][2];
        qb[0][0] = ldg8(qp); qb[0][1] = ldg8(qp + 32); qb[1][0] = ldg8(qp + 16 * 64); qb[1][1] = ldg8(qp + 16 * 64 + 32);
        float carry[2] = {0.f, 0.f};
        f32x4 o[2][4];
#pragma unroll
        for (int qs = 0; qs < 2; ++qs)
#pragma unroll
            for (int dt = 0; dt < 4; ++dt) o[qs][dt] = (f32x4){0.f, 0.f, 0.f, 0.f};
        const bf16_t* kblk = QK + ((size_t)((16 + h) * 512) + b * 128) * 4096 + klane;
        const bf16_t* vblk = VT + ((size_t)(h * 512) + b * 128) * 4096 + vlane;
        const int kt0 = (qt32 * 32 + 31) >> 6;
        bf16x8 kf[8]; load_kfrag(kf, kblk + (size_t)kt0 * 4096);
        asm volatile("" :: "v"(kf[0]), "v"(kf[1]), "v"(kf[2]), "v"(kf[3]), "v"(kf[4]), "v"(kf[5]), "v"(kf[6]), "v"(kf[7]));
        for (int kt = kt0; kt >= 0; --kt) {
            bf16x8 vf[8], kn[8];
            load_vfrag(vf, vblk + (size_t)kt * 4096);
            load_kfrag(kn, kblk + (size_t)(kt > 0 ? kt - 1 : 0) * 4096);
            SB0();
            f32x4 sq[2][2][2];
#pragma unroll
            for (int qs = 0; qs < 2; ++qs)
#pragma unroll
                for (int c2 = 0; c2 < 2; ++c2)
#pragma unroll
                    for (int e = 0; e < 2; ++e) { f32x4 a = mfma16(kf[(c2 * 2 + e) * 2], qb[qs][0], (f32x4){0.f, 0.f, 0.f, 0.f}); sq[qs][c2][e] = mfma16(kf[(c2 * 2 + e) * 2 + 1], qb[qs][1], a); }
#pragma unroll
            for (int qs = 0; qs < 2; ++qs) {
                const int tq = tq0 + 16 * qs;
                float ln[2][8], ls[2][8], E[2][8], C[2], Gs[2];
#pragma unroll
                for (int c2 = 0; c2 < 2; ++c2)
#pragma unroll
                    for (int x = 0; x < 8; ++x) {
                        const float z = sq[qs][c2][x >> 2][x & 3] * (0.125f * 1.4426950408889634f);
                        const bool valid = (kt * 64 + 32 * c2 + 8 * g + x) < tq;
                        const float sp = fmaxf(z, 0.f) + __builtin_amdgcn_logf(1.f + __builtin_amdgcn_exp2f(-fabsf(z)));
                        ln[c2][x] = valid ? -sp : 0.f;
                        ls[c2][x] = valid ? (z - sp) : -INFINITY;
                    }
#pragma unroll
                for (int c2 = 0; c2 < 2; ++c2) { float run = 0.f;
#pragma unroll
                    for (int x = 7; x >= 0; --x) { E[c2][x] = run; run += ln[c2][x]; }
                    const float t1 = shx(run, lane, 16), t2 = shx(run, lane, 32), t3 = shx(run, lane, 48);
                    C[c2] = (run + t1) + (t2 + t3);
                    Gs[c2] = (((g ^ 1) > g) ? t1 : 0.f) + (((g ^ 2) > g) ? t2 : 0.f) + (((g ^ 3) > g) ? t3 : 0.f);
                }
                const float base1 = carry[qs] + Gs[1], base0 = carry[qs] + C[1] + Gs[0];
                float pf[2][8];
#pragma unroll
                for (int x = 0; x < 8; ++x) { pf[1][x] = __builtin_amdgcn_exp2f(ls[1][x] + E[1][x] + base1); pf[0][x] = __builtin_amdgcn_exp2f(ls[0][x] + E[0][x] + base0); }
                carry[qs] += C[0] + C[1];
#pragma unroll
                for (int c2 = 0; c2 < 2; ++c2) { const bf16x8 pb = pack8(pf[c2]);
#pragma unroll
                    for (int dt = 0; dt < 4; ++dt) o[qs][dt] = mfma16(vf[c2 * 4 + dt], pb, o[qs][dt]); }
            }
            SB0();
            asm volatile("" :: "v"(kn[0]), "v"(kn[1]), "v"(kn[2]), "v"(kn[3]), "v"(kn[4]), "v"(kn[5]), "v"(kn[6]), "v"(kn[7]));
#pragma unroll
            for (int x = 0; x < 8; ++x) kf[x] = kn[x];
            if (__all(fmaxf(carry[0], carry[1]) < -150.1f)) break;
        }
#pragma unroll
        for (int qs = 0; qs < 2; ++qs)
#pragma unroll
            for (int dt = 0; dt < 4; ++dt) *(u32x2*)(O + (tokq + 16 * qs) * 1024 + h * 64 + dt * 16 + 4 * g) = pack4(o[qs][dt][0], o[qs][dt][1], o[qs][dt][2], o[qs][dt][3]);
    }
}

__device__ __forceinline__ void b_p2_phase(const int tid, const int bid, LAS unsigned char* lds, int half, bf16_t* U, const bf16_t* VTB, const float* part, const float* w_s, const float* b_s, const float* v_gain) {
    const int lane = tid & 63, wave = __builtin_amdgcn_readfirstlane(tid >> 6), j = lane & 15, g = lane >> 4;
    LAS bf16_t* sW = (LAS bf16_t*)lds;
    LAS float* sR = (LAS float*)(lds + 34816);
    for (int unit = bid; unit < 1024; unit += gridDim.x) {
        const int w = unit >> 3, grp = unit & 7, wtok0 = w * 128;
        if (tid < 128) { const float* pp = part + (size_t)(wtok0 + tid) * 24; float s = 0.f;
#pragma unroll
            for (int q = 0; q < 24; ++q) s += pp[q];
            sR[tid] = rsqrtf(s * (1.f / 3072.f) + EPS); }
        __syncthreads();
#pragma unroll 8
        for (int idx = tid; idx < 16384; idx += 512) { const int i = idx >> 7, jj = idx & 127;
            const float val = ((i >> 6) >= (jj >> 6)) ? w_s[(size_t)(grp * 128 + i) * 128 + jj] * sR[jj] : 0.f;
            sW[i * 136 + jj] = (bf16_t)f2bf(val); }
        __syncthreads();
#pragma unroll 1
        for (int ct = wave; ct < 24; ct += 8) {
            f32x4 acc[8];
#pragma unroll
            for (int it = 0; it < 8; ++it) acc[it] = (f32x4){0.f, 0.f, 0.f, 0.f};
#pragma unroll
            for (int c4 = 0; c4 < 4; ++c4) {
                const int vrow = grp * 384 + ct * 16 + j; const bf16x8 va = ldg8(VTB + ((size_t)(vrow >> 6) * 256 + (wtok0 >> 6) + (c4 >> 1)) * 4096 + (vrow & 63) * 64 + 32 * (c4 & 1) + 8 * g);
#pragma unroll
                for (int it = 0; it < 8; ++it) { const bf16x8 wb = *(const LAS bf16x8*)(sW + (it * 16 + j) * 136 + 32 * c4 + 8 * g); acc[it] = mfma16(va, wb, acc[it]); }
            }
            const int ch0 = grp * 384 + ct * 16 + 4 * g;
            const f32x4 gn = *(const f32x4*)(v_gain + ch0);
#pragma unroll
            for (int it = 0; it < 8; ++it) { const int io = it * 16 + j; const float bs = b_s[grp * 128 + io];
                u32x2* up = (u32x2*)(U + ((size_t)half * 16384 + wtok0 + io) * 3072 + ch0); float uf[4]; unpack4(*up, uf);
                *up = pack4(uf[0] * (acc[it][0] * gn[0] + bs), uf[1] * (acc[it][1] * gn[1] + bs), uf[2] * (acc[it][2] * gn[2] + bs), uf[3] * (acc[it][3] * gn[3] + bs)); }
        }
        __syncthreads();
    }
}

__device__ __forceinline__ void c_p1_phase(const int tid, const int bid, LAS unsigned char* lds, bf16_t* QKR, const bf16_t* VT, const float* abuf, float* dbuf, bf16_t* ATT, bf16_t* DS, const float* wgate, const float* bgate) {
    const int lane = tid & 63, wave = __builtin_amdgcn_readfirstlane(tid >> 6), j = lane & 15, g = lane >> 4;
    LAS bf16_t* sQ = (LAS bf16_t*)lds;
    LAS bf16_t* sK = (LAS bf16_t*)(lds + 17408);
    LAS bf16_t* sKd = (LAS bf16_t*)(lds + 34816);
    LAS float* sA = (LAS float*)(lds + 53248);
    LAS float* sSeg = (LAS float*)(lds + 57344);
    const int kch = tid & 127, seg = tid >> 7;
    for (int unit = bid; unit < 2048; unit += gridDim.x) {
        const int c = unit & 127, h = (unit >> 7) & 3, b = unit >> 9;
        const size_t tok0 = (size_t)b * SEQ + (size_t)c * 64;
        for (int idx = tid; idx < 1024; idx += 512) sA[idx] = abuf[tok0 * 16 + idx];
        float wv[16];
#pragma unroll
        for (int r = 0; r < 16; ++r) wv[r] = wgate[r * 512 + h * 128 + kch];
        const float bg = bgate[h * 128 + kch];
        __syncthreads();
        float cum[16]; float run = 0.f;
#pragma unroll
        for (int i = 0; i < 16; ++i) { const int s = seg * 16 + i; float x = bg;
#pragma unroll
            for (int r = 0; r < 16; ++r) x += sA[s * 16 + r] * wv[r];
            const float la = -(fmaxf(-x, 0.f) + __logf(1.f + __expf(-fabsf(x)))) * (1.f / 16.f);
            run += la; cum[i] = run; }
        sSeg[seg * 128 + kch] = run;
        __syncthreads();
        const float s0 = sSeg[kch], s1 = sSeg[128 + kch], s2 = sSeg[256 + kch], s3 = sSeg[384 + kch];
        const float pre = (seg > 0 ? s0 : 0.f) + (seg > 1 ? s1 : 0.f) + (seg > 2 ? s2 : 0.f), blast = (s0 + s1) + (s2 + s3);
#pragma unroll
        for (int i = 0; i < 16; ++i) { const int s = seg * 16 + i; const float bb = pre + cum[i];
            bf16_t* qp = QKR + ((size_t)((2 * h + (kch >> 6)) * 512) + (tok0 >> 6)) * 4096 + s * 64 + (kch & 63);
            const float qv = bf2f(qp[0]), kv = bf2f(qp[(size_t)8 * 512 * 4096]);
            const bf16_t qb = (bf16_t)f2bf(qv * __expf(bb) * 0.08838834764831845f);
            qp[0] = qb; sQ[s * 136 + kch] = qb; sK[s * 136 + kch] = (bf16_t)f2bf(kv * __expf(-bb)); sKd[kch * 72 + s] = (bf16_t)f2bf(kv * __expf(blast - bb)); }
        if (seg == 0) dbuf[(size_t)unit * 128 + kch] = __expf(blast);
        __syncthreads();
        for (int tl = wave; tl < 16; tl += 8) { const int ti = tl >> 2, si = tl & 3;
            f32x4 a = (f32x4){0.f, 0.f, 0.f, 0.f};
            if (si <= ti) {
#pragma unroll
                for (int c4 = 0; c4 < 4; ++c4) { const bf16x8 ka = *(const LAS bf16x8*)(sK + (si * 16 + j) * 136 + 32 * c4 + 8 * g), qb = *(const LAS bf16x8*)(sQ + (ti * 16 + j) * 136 + 32 * c4 + 8 * g); a = mfma16(ka, qb, a); } }
            const int tt = ti * 16 + j, sb = si * 16 + 4 * g;
            *(u32x2*)(ATT + ((size_t)unit * 64 + tt) * 64 + sb) = pack4(sb + 0 <= tt ? a[0] : 0.f, sb + 1 <= tt ? a[1] : 0.f, sb + 2 <= tt ? a[2] : 0.f, sb + 3 <= tt ? a[3] : 0.f); }
        f32x4 acc[2][8];
#pragma unroll
        for (int vv = 0; vv < 2; ++vv)
#pragma unroll
            for (int kt = 0; kt < 8; ++kt) acc[vv][kt] = (f32x4){0.f, 0.f, 0.f, 0.f};
#pragma unroll
        for (int c2 = 0; c2 < 2; ++c2) { bf16x8 vb[2];
#pragma unroll
            for (int vv = 0; vv < 2; ++vv) { const int vrow = h * 256 + (2 * wave + vv) * 16 + j; vb[vv] = ldg8(VT + ((size_t)(vrow >> 6) * 512 + (tok0 >> 6)) * 4096 + (vrow & 63) * 64 + 32 * c2 + 8 * g); }
#pragma unroll
            for (int kt = 0; kt < 8; ++kt) { const bf16x8 ka = *(const LAS bf16x8*)(sKd + (kt * 16 + j) * 72 + 32 * c2 + 8 * g);
#pragma unroll
                for (int vv = 0; vv < 2; ++vv) acc[vv][kt] = mfma16(ka, vb[vv], acc[vv][kt]); } }
#pragma unroll
        for (int vv = 0; vv < 2; ++vv)
#pragma unroll
            for (int kt = 0; kt < 8; ++kt) *(u32x2*)(DS + ((size_t)unit * 256 + (2 * wave + vv) * 16 + j) * 128 + kt * 16 + 4 * g) = pack4(acc[vv][kt][0], acc[vv][kt][1], acc[vv][kt][2], acc[vv][kt][3]);
        __syncthreads();
    }
}
__device__ __forceinline__ void c_p2_phase(const int tid, const int bid, bf16_t* DS, const float* dbuf) {
    for (int item = bid * 512 + tid; item < 131072; item += gridDim.x * 512) {
        const int bh = item >> 13, e4 = (item & 8191) * 4, kch = e4 & 127;
        float S0 = 0.f, S1 = 0.f, S2 = 0.f, S3 = 0.f;
        for (int c0 = 0; c0 < 128; c0 += 16) {
            u32x2 dv[16]; f32x4 dd[16];
#pragma unroll
            for (int u = 0; u < 16; ++u) { const size_t unit = (size_t)bh * 128 + c0 + u; dv[u] = *(const u32x2*)(DS + unit * 32768 + e4); dd[u] = *(const f32x4*)(dbuf + unit * 128 + kch); }
#pragma unroll
            for (int u = 0; u < 16; ++u) { const size_t unit = (size_t)bh * 128 + c0 + u; float f[4]; unpack4(dv[u], f);
                *(u32x2*)(DS + unit * 32768 + e4) = pack4(S0, S1, S2, S3);
                S0 = S0 * dd[u][0] + f[0]; S1 = S1 * dd[u][1] + f[1]; S2 = S2 * dd[u][2] + f[2]; S3 = S3 * dd[u][3] + f[3]; }
        }
    }
}
__device__ __forceinline__ void c_p3_phase(const int tid, const int bid, const bf16_t* QKR, const bf16_t* VT, const bf16_t* ATT, const bf16_t* DS, bf16_t* O, const float* ogain) {
    const int lane = tid & 63, wave = __builtin_amdgcn_readfirstlane(tid >> 6), j = lane & 15, g = lane >> 4;
    const int gw = bid * 8 + wave, NGW = gridDim.x * 8;
    for (int id = gw; id < 4096; id += NGW) {
        const int tq2 = id & 1, unit = id >> 1, c = unit & 127, h = (unit >> 7) & 3, b = unit >> 9;
        const size_t tok0 = (size_t)b * SEQ + (size_t)c * 64;
        f32x4 acc[2][16];
#pragma unroll
        for (int qs = 0; qs < 2; ++qs)
#pragma unroll
            for (int vt = 0; vt < 16; ++vt) acc[qs][vt] = (f32x4){0.f, 0.f, 0.f, 0.f};
        if (c > 0) {
#pragma unroll 1
            for (int kc = 0; kc < 4; ++kc) {
                const bf16_t* qp = QKR + ((size_t)((2 * h + (kc >> 1)) * 512) + (tok0 >> 6)) * 4096 + (tq2 * 32 + j) * 64 + 32 * (kc & 1) + 8 * g;
                const bf16x8 qb0 = ldg8(qp), qb1 = ldg8(qp + 16 * 64);
#pragma unroll
                for (int vh = 0; vh < 2; ++vh) {
                    bf16x8 sa[8];
#pragma unroll
                    for (int v8 = 0; v8 < 8; ++v8) sa[v8] = ldg8(DS + ((size_t)unit * 256 + (vh * 8 + v8) * 16 + j) * 128 + 32 * kc + 8 * g);
                    SB0();
#pragma unroll
                    for (int v8 = 0; v8 < 8; ++v8) { acc[0][vh * 8 + v8] = mfma16(sa[v8], qb0, acc[0][vh * 8 + v8]); acc[1][vh * 8 + v8] = mfma16(sa[v8], qb1, acc[1][vh * 8 + v8]); }
                    SB0(); } }
        }
#pragma unroll 1
        for (int sc = 0; sc < 2; ++sc) {
            const bf16_t* ap = ATT + ((size_t)unit * 64 + tq2 * 32 + j) * 64 + 32 * sc + 8 * g;
            const bf16x8 ab0 = ldg8(ap), ab1 = ldg8(ap + 16 * 64);
#pragma unroll
            for (int vh = 0; vh < 2; ++vh) {
                bf16x8 va[8];
#pragma unroll
                for (int v8 = 0; v8 < 8; ++v8) { const int vt = vh * 8 + v8; va[v8] = ldg8(VT + ((size_t)((4 * h + (vt >> 2)) * 512) + (tok0 >> 6)) * 4096 + ((vt & 3) * 16 + j) * 64 + 32 * sc + 8 * g); }
                SB0();
#pragma unroll
                for (int v8 = 0; v8 < 8; ++v8) { acc[0][vh * 8 + v8] = mfma16(va[v8], ab0, acc[0][vh * 8 + v8]); acc[1][vh * 8 + v8] = mfma16(va[v8], ab1, acc[1][vh * 8 + v8]); }
                SB0(); } }
#pragma unroll
        for (int qs = 0; qs < 2; ++qs) {
            const size_t tok = tok0 + tq2 * 32 + qs * 16 + j;
            float ss = 0.f;
#pragma unroll
            for (int vt = 0; vt < 16; ++vt) ss += (acc[qs][vt][0] * acc[qs][vt][0] + acc[qs][vt][1] * acc[qs][vt][1]) + (acc[qs][vt][2] * acc[qs][vt][2] + acc[qs][vt][3] * acc[qs][vt][3]);
            ss += shx(ss, lane, 16); ss += shx(ss, lane, 32);
            const float rs = rsqrtf(ss * (1.f / 256.f) + EPS);
#pragma unroll
            for (int vt = 0; vt < 16; ++vt) { const int v0 = vt * 16 + 4 * g;
                float rf[4]; unpack4(*(const u32x2*)(QKR + ((size_t)((16 + 4 * h + (vt >> 2)) * 512) + (tok0 >> 6)) * 4096 + (tq2 * 32 + qs * 16 + j) * 64 + (v0 & 63)), rf);
                const f32x4 og = *(const f32x4*)(ogain + v0);
                float ov[4];
#pragma unroll
                for (int e = 0; e < 4; ++e) ov[e] = acc[qs][vt][e] * rs * og[e] * (rf[e] / (1.f + __expf(-rf[e])));
                *(u32x2*)(O + tok * 1024 + h * 256 + v0) = pack4(ov[0], ov[1], ov[2], ov[3]); }
        }
    }
}

#define XB_TMO      128
#define XB_XCNT(j)  (256  + 64 * (j))
#define XB_XSUB(j)  (1280 + 64 * (j))
#define XB_XGEN(j)  (2304 + 64 * (j))
#define XB_TOP      3328
#define XB_TOPGEN   3392
#define XCD_BAR_WORDS 3456
#define XB_SPIN_CAP (1u << 18)
__device__ __forceinline__ unsigned xb_ld(unsigned* p)              { return __hip_atomic_load(p, __ATOMIC_RELAXED, __HIP_MEMORY_SCOPE_AGENT); }
__device__ __forceinline__ unsigned xb_add(unsigned* p, unsigned v) { return __hip_atomic_fetch_add(p, v, __ATOMIC_RELAXED, __HIP_MEMORY_SCOPE_AGENT); }
__device__ __forceinline__ unsigned xb_xcc_id() { return (unsigned)__builtin_amdgcn_s_getreg((3 << 11) | 20) & 0xFu; }
#define XB_SPIN(cond, bar) do { unsigned _sp = 0; while (cond) { __builtin_amdgcn_s_sleep(1); \
    if ((++_sp & 255u) == 0u) { if (xb_ld(&(bar)[XB_TMO])) break; if (_sp > XB_SPIN_CAP) { atomicAdd(&(bar)[XB_TMO], 1u); break; } } } } while (0)
__device__ __forceinline__ void xcd_barrier_complete(unsigned* bar, unsigned x, unsigned& nloc, unsigned& nx) {
    const unsigned G = gridDim.x * gridDim.y * gridDim.z;
    unsigned sum, cnt, mine, sp = 0u;
    for (;;) {
        sum = 0u; cnt = 0u; mine = 0u;
#pragma unroll
        for (unsigned j = 0; j < 16; ++j) { const unsigned c = xb_ld(&bar[XB_XCNT(j)]); sum += c; cnt += (c > 0u) ? 1u : 0u; mine = (j == x) ? c : mine; }
        if (sum == G) break;
        __builtin_amdgcn_s_sleep(1);
        if ((++sp & 255u) == 0u) { if (xb_ld(&bar[XB_TMO])) break; if (sp > XB_SPIN_CAP) { atomicAdd(&bar[XB_TMO], 1u); break; } }
    }
    nloc = mine > 0u ? mine : 1u; nx = cnt > 0u ? cnt : 1u;
}
__device__ __forceinline__ void xcd_barrier(unsigned* bar, volatile LAS unsigned* st) {
    asm volatile("s_waitcnt vmcnt(0)" ::: "memory");
    __syncthreads();
    if (threadIdx.x == 0) {
        const unsigned x = xb_xcc_id();
        __builtin_amdgcn_s_waitcnt(0);
        unsigned nloc = st[0], nx = st[1];
        if (nloc == 0u) { xcd_barrier_complete(bar, x, nloc, nx); st[0] = nloc; st[1] = nx; }
        const unsigned old = xb_add(&bar[XB_XSUB(x)], 1u);
        const unsigned gen = old / nloc;
        if (old + 1u == (gen + 1u) * nloc) {
            __builtin_amdgcn_fence(__ATOMIC_RELEASE, "agent");
            asm volatile("s_waitcnt vmcnt(0)" ::: "memory");
            const unsigned og = xb_add(&bar[XB_TOP], 1u);
            const unsigned tg = og / nx;
            if (og + 1u == (tg + 1u) * nx) xb_add(&bar[XB_TOPGEN], 1u);
            else XB_SPIN(xb_ld(&bar[XB_TOPGEN]) == tg, bar);
            __builtin_amdgcn_fence(__ATOMIC_ACQUIRE, "agent");
            xb_add(&bar[XB_XGEN(x)], 1u);
            asm volatile("s_waitcnt vmcnt(0)" ::: "memory");
        } else {
            XB_SPIN(xb_ld(&bar[XB_XGEN(x)]) == gen, bar);
            __builtin_amdgcn_fence(__ATOMIC_ACQUIRE, "agent");
            asm volatile("s_waitcnt vmcnt(0)" ::: "memory");
        }
    }
    __syncthreads();
}
constexpr int LDS_BYTES = 135168;
__global__ void __launch_bounds__(512, 2) fwd_kernel(Params p) {
    extern __shared__ __attribute__((aligned(16))) unsigned char lds_raw[];
    LAS unsigned char* lds = (LAS unsigned char*)lds_raw;
    const int G = gridDim.x;
    const int ph_lo = p.ph_lo, ph_hi = p.ph_hi;
    volatile LAS unsigned* bst = (volatile LAS unsigned*)(lds + 131072);
    if (threadIdx.x == 0) { bst[0] = 0u; bst[1] = 0u; (void)xb_add((unsigned*)(p.ws + OFF_BAR) + XB_XCNT(xb_xcc_id()), 1u); }
    __syncthreads();
#pragma unroll 1
    for (int ph = ph_lo; ph < ph_hi; ++ph) {
        const CAS Params* pp = (const CAS Params*)__builtin_amdgcn_kernarg_segment_ptr(); asm volatile("" : "+s"(pp));
        unsigned char* ws = as_global(pp->ws);
#define IN(k) as_global(pp->in[k])
        float* const outp = as_global(pp->out);
        float* mod = (float*)(ws + OFF_MOD);
        bf16_t* Wt = (bf16_t*)(ws + OFF_W);
        bf16_t* Hb = (bf16_t*)(ws + OFF_H);
        unsigned char* big = ws + OFF_BIG;
        int tid = threadIdx.x; asm volatile("" : "+v"(tid));
        int bid = blockIdx.x; asm volatile("" : "+s"(bid));
        const PhTab* tp = &PHT; asm volatile("" : "+s"(tp));
        const int type = tp->t[ph][0], L = tp->t[ph][1], arg = tp->t[ph][2], xin_flag = tp->t[ph][3];
        const float* modL = mod + (size_t)L * 4 * 6144;
        const float* xcur = (xin_flag & 1) ? IN(0) : (const float*)outp;
#ifndef PHASE_MASK
#define PHASE_MASK 0xfff
#endif
#define PM(k) ((PHASE_MASK >> (k)) & 1)
        switch (type) {
        case 0: if (PM(0)) p0_phase(tid, bid, pp, ws, lds); break;
        case 1: if (PM(1) && arg < 2) {
            const float* gain = (arg == 0 ? IN(4) : IN(5)) + L * 1024;
            norm_phase(tid, bid, xcur, gain, modL + (arg == 0 ? 0 : 3072), modL + (arg == 0 ? 1024 : 4096), Hb);
        } break;
        case 2: if (PM(2)) {
            pg8::Gemm g{Hb, Wt + (L == 0 ? WA_IN : WD_IN), NTOK, 2048, 1024};
            pg8::EpiBf<0, false, true, 1, 512> E; E.part = nullptr; E.abuf = nullptr; E.O = (bf16_t*)(big + B_QK); E.ldc = 0;
            pg8::StaticOrder S; S.init(NTOK, 2048, G, bid); pg8::gemm_phase<pg8::EpiBf<0, false, true, 1, 512>, pg8::StaticOrder, true, true>(tid, lds, g, S, E);
        } break;
        case 12: if (PM(2)) {
            const bf16_t* W = Wt + (arg == 0 ? WA_IN + (size_t)2048 * 1024 : (arg == 1 ? WD_IN + (size_t)2048 * 1024 : WC_IN + (size_t)2304 * 1024));
            pg8::Gemm g{W, Hb, 1024, NTOK, 1024};
            pg8::EpiBf<0, false, true, 512, 1> E; E.part = nullptr; E.abuf = nullptr; E.O = (bf16_t*)(big + B_VT); E.ldc = 0;
            pg8::StaticOrder S; S.init(1024, NTOK, G, bid); pg8::gemm_phase<pg8::EpiBf<0, false, true, 512, 1>, pg8::StaticOrder, true, true>(tid, lds, g, S, E);
        } break;
        case 13: if (PM(2)) {
            pg8::Gemm g{Hb, Wt + WC_IN, NTOK, 2304, 1024};
            pg8::EpiBf<0, false, true, 1, 512, 8> E; E.part = nullptr; E.abuf = (float*)(ws + OFF_ABUF); E.O = (bf16_t*)(big + B_QK); E.ldc = 0;
            pg8::StaticOrder S; S.init(NTOK, 2304, G, bid); pg8::gemm_phase<pg8::EpiBf<0, false, true, 1, 512, 8>, pg8::StaticOrder, true, true>(tid, lds, g, S, E);
        } break;
        case 10: if (PM(10)) {
            pg8::Gemm g{Hb, Wt + W_F1 + (size_t)L * 4194304, NTOK, 4096, 1024};
            pg8::EpiBf<2, false> E; E.part = nullptr; E.abuf = nullptr; E.O = (bf16_t*)(big + B_HID); E.ldc = 4096;
            pg8::StaticOrder S; S.init(NTOK, 4096, G, bid); pg8::gemm_phase<pg8::EpiBf<2, false>, pg8::StaticOrder, true, true>(tid, lds, g, S, E);
        } break;
        case 11: if (PM(11)) {
            pg8::Gemm g{Hb + (size_t)arg * 16384 * 1024, Wt + WB_IN, 16384, 3072, 1024};
            pg8::EpiBf<1, false> E; E.part = nullptr; E.abuf = nullptr; E.O = (bf16_t*)(big + B_U) + (size_t)arg * 16384 * 3072; E.ldc = 3072;
            pg8::StaticOrder S; S.init(16384, 3072, G, bid); pg8::gemm_phase<pg8::EpiBf<1, false>, pg8::StaticOrder, true, true>(tid, lds, g, S, E);
        } break;
        case 14: if (PM(11)) {
            pg8::Gemm g{Wt + WB_IN + (size_t)3072 * 1024, Hb + (size_t)arg * 16384 * 1024, 3072, 16384, 1024};
            pg8::EpiBf<1, true, true, 256, 1> E; E.part = (float*)(ws + OFF_PART); E.abuf = nullptr; E.O = (bf16_t*)(big + B_VTB); E.ldc = 0;
            pg8::StaticOrder S; S.init(3072, 16384, G, bid); pg8::gemm_phase<pg8::EpiBf<1, true, true, 256, 1>, pg8::StaticOrder, true, true>(tid, lds, g, S, E);
        } break;
        case 3: if (PM(3)) {
            pg8::Gemm g{Hb, Wt + (L == 0 ? WA_OUT : (L == 2 ? WC_OUT : WD_OUT)), NTOK, 1024, 1024};
            pg8::EpiResid E; E.xin = xcur; E.xout = outp; E.gate = modL + 2048;
            pg8::StaticOrder S; S.init(NTOK, 1024, G, bid); pg8::gemm_phase<pg8::EpiResid, pg8::StaticOrder, true, true>(tid, lds, g, S, E);
        } break;
        case 15: if (PM(3)) {
            pg8::Gemm g{(const bf16_t*)(big + B_U), Wt + WB_OUT, NTOK, 1024, 3072};
            pg8::EpiResid E; E.xin = xcur; E.xout = outp; E.gate = modL + 2048;
            pg8::StaticOrder S; S.init(NTOK, 1024, G, bid); pg8::gemm_phase<pg8::EpiResid, pg8::StaticOrder, true, true>(tid, lds, g, S, E);
        } break;
        case 16: if (PM(3)) {
            pg8::Gemm g{(const bf16_t*)(big + B_HID), Wt + W_F2 + (size_t)L * 4194304, NTOK, 1024, 4096};
            pg8::EpiResid E; E.xin = xcur; E.xout = outp; E.gate = modL + 5120;
            pg8::StaticOrder S; S.init(NTOK, 1024, G, bid); pg8::gemm_phase<pg8::EpiResid, pg8::StaticOrder, true, true>(tid, lds, g, S, E);
        } break;
        case 17: if (PM(4)) qknorm_phase(tid, bid, (bf16_t*)(big + B_QK), IN(9), IN(10)); break;
        case 4: if (PM(4)) attn_a_phase(tid, bid, lds, (const bf16_t*)(big + B_QK), (const bf16_t*)(big + B_VT), Hb, IN(11)); break;
        case 5: if (PM(5)) b_p2_phase(tid, bid, lds, arg, (bf16_t*)(big + B_U), (const bf16_t*)(big + B_VTB), (const float*)(ws + OFF_PART), IN(15), IN(16), IN(14)); break;
        case 6: if (PM(6)) c_p1_phase(tid, bid, lds, (bf16_t*)(big + B_QK), (const bf16_t*)(big + B_VT), (const float*)(ws + OFF_ABUF), (float*)(ws + OFF_DBUF), (bf16_t*)(big + B_ATT), (bf16_t*)(big + B_DS), IN(19), IN(20)); break;
        case 7: if (PM(7)) c_p2_phase(tid, bid, (bf16_t*)(big + B_DS), (const float*)(ws + OFF_DBUF)); break;
        case 8: if (PM(8)) c_p3_phase(tid, bid, (const bf16_t*)(big + B_QK), (const bf16_t*)(big + B_VT), (const bf16_t*)(big + B_ATT), (const bf16_t*)(big + B_DS), Hb, IN(21)); break;
        default: if (PM(9)) attn_d_phase(tid, bid, (const bf16_t*)(big + B_QK), (const bf16_t*)(big + B_VT), Hb); break;
        }
        if (ph + 1 < ph_hi && !(xin_flag & 2)) { if (ph_hi > 4096) cg::this_grid().sync(); else xcd_barrier((unsigned*)(ws + OFF_BAR), bst); }
    }
}


#ifdef DEBUG_DUMP
__global__ void dump_kernel(float* out, const unsigned char* ws, int which) {
    const unsigned char* big = ws + OFF_BIG;
    const bf16_t* QKR = (const bf16_t*)(big + B_QK); const bf16_t* VT = (const bf16_t*)(big + B_VT); const bf16_t* DS = (const bf16_t*)(big + B_DS); const bf16_t* ATT = (const bf16_t*)(big + B_ATT);
    const float* abuf = (const float*)(ws + OFF_ABUF); const float* dbuf = (const float*)(ws + OFF_DBUF); const bf16_t* Hb = (const bf16_t*)(ws + OFF_H);
    for (size_t i = (size_t)blockIdx.x * blockDim.x + threadIdx.x; i < (size_t)NTOK * DM; i += (size_t)gridDim.x * blockDim.x) {
        float v = 0.f;
        if (which == 0) v = bf2f(QKR[2 * i]) + bf2f(QKR[2 * i + 1]) + bf2f(VT[i]) + abuf[i & 524287];
        else if (which == 1) v = bf2f(DS[2 * i]) + bf2f(DS[2 * i + 1]) + bf2f(ATT[i & 8388607]) + dbuf[i & 262143] + bf2f(QKR[2 * i]) + bf2f(QKR[2 * i + 1]);
        else if (which == 2) v = bf2f(DS[2 * i]) + bf2f(DS[2 * i + 1]);
        else v = bf2f(Hb[i]);
        out[i] = v;
    }
}
#endif
extern "C" void kernel_launch(void* const* d_in, const int* in_sizes, int n_in, void* d_out, int out_size, void* d_ws, size_t ws_size, hipStream_t stream) {
    static int grid = 0;
    if (grid == 0) {
        if (n_in != 25 || out_size != NTOK * DM || ws_size < WS_NEED) { fprintf(stderr, "kernel_launch: unexpected shapes (n_in %d, out %d, ws %zu); nothing launched\n", n_in, out_size, ws_size); grid = -1; return; }
        int dev = 0, cus = 0, per_cu = 0;
        (void)hipGetDevice(&dev);
        (void)hipDeviceGetAttribute(&cus, hipDeviceAttributeMultiprocessorCount, dev);
        if (hipFuncSetAttribute((const void*)fwd_kernel, hipFuncAttributeMaxDynamicSharedMemorySize, LDS_BYTES) != hipSuccess) { fprintf(stderr, "kernel_launch: hipFuncSetAttribute failed\n"); grid = -1; return; }
        if (hipOccupancyMaxActiveBlocksPerMultiprocessor(&per_cu, (const void*)fwd_kernel, 512, LDS_BYTES) != hipSuccess || per_cu < 1) { fprintf(stderr, "kernel_launch: occupancy query says %d\n", per_cu); per_cu = 1; }
        (void)hipGetLastError();
        grid = cus * per_cu;
        if (grid < 1) grid = 256;
    }
    if (grid < 0) return;
    Params p{};
    for (int i = 0; i < 25; ++i) p.in[i] = (const float*)d_in[i];
    p.out = (float*)d_out; p.ws = (unsigned char*)d_ws;
#ifdef DEBUG_MEMSET
    (void)hipMemsetAsync(d_ws, 0, WS_NEED, stream); (void)hipMemsetAsync(d_out, 0, (size_t)out_size * 4, stream);
#endif
    (void)hipMemsetAsync((unsigned char*)d_ws + OFF_BAR, 0, XCD_BAR_WORDS * 4, stream);
#if MULTI_LAUNCH
#ifndef NPH_RUN
#define NPH_RUN NPHASE
#endif
    for (int ph = 0; ph < NPH_RUN; ++ph) { p.ph_lo = ph; p.ph_hi = ph + 1; hipLaunchKernelGGL(fwd_kernel, dim3(grid), dim3(512), LDS_BYTES, stream, p); }
#ifdef DEBUG_DUMP
    hipLaunchKernelGGL(dump_kernel, dim3(2048), dim3(256), 0, stream, (float*)d_out, (const unsigned char*)d_ws, DEBUG_DUMP);
#endif
#else
    p.ph_lo = 0; p.ph_hi = NPHASE;
    void* args[] = {&p};
    hipError_t e = hipLaunchCooperativeKernel((const void*)fwd_kernel, dim3(grid), dim3(512), args, LDS_BYTES, stream);
    if (e != hipSuccess) fprintf(stderr, "kernel_launch: cooperative launch failed: %s (grid %d)\n", hipGetErrorString(e), grid);
#endif
}
```

```cpp
#include <hip/hip_runtime.h>
#include <hip/hip_cooperative_groups.h>
#include <cstdio>
#include <cstdint>
namespace cg = cooperative_groups;

#ifndef MULTI_LAUNCH
#define MULTI_LAUNCH 0
#endif

#define LAS __attribute__((address_space(3)))
typedef unsigned short bf16_t;
typedef short bf16x8 __attribute__((ext_vector_type(8)));
typedef float f32x4 __attribute__((ext_vector_type(4)));
typedef float f32x2 __attribute__((ext_vector_type(2)));
typedef unsigned u32x4 __attribute__((ext_vector_type(4)));
typedef unsigned u32x2 __attribute__((ext_vector_type(2)));

namespace pg8 {
constexpr int BM = 256, BK = 64, HALF = 128, HTB = HALF * BK * 2, STAGE_BYTES = 8 * HTB, NXCD = 8, WGM = 8;
__host__ __device__ __forceinline__ int lds_byte(int r, int c) { const int st = (r >> 4) * 2 + (c >> 5), rr = r & 15, cc = c & 31, ob = rr * 64 + cc * 2; return st * 1024 + (ob ^ (((ob >> 9) & 1) << 5)); }
__host__ __device__ __forceinline__ void stage_rc(int b, int& R, int& C) { const int st = b / 1024, sb = b % 1024, swz = sb ^ (((sb >> 9) & 1) << 5); R = (st >> 1) * 16 + swz / 64; C = (st & 1) * 32 + (swz % 64) / 2; }
__host__ __device__ __forceinline__ int perm32(int rho) { const int n = rho >> 4, i = rho & 15; return 8 * (i >> 2) + 4 * n + (i & 3); }
struct Unit { int pm, pn; };
struct Gemm { const bf16_t* A; const bf16_t* Bt; int M, N, K; };
struct StaticOrder {
    int nM, nN, nwg, G, c;
    __host__ __device__ void init(int M, int N, int G_, int c_) { nM = M / BM; nN = N / BM; nwg = nM * nN; G = G_; c = c_; }
    __host__ __device__ bool next(int i, Unit& u) const {
        const int L = i * G + c; if (L >= nwg) return false;
        int wgid = L; { const int q = nwg / NXCD, r = nwg % NXCD, xcd = wgid % NXCD, off = wgid / NXCD; wgid = (xcd < r ? xcd * (q + 1) : r * (q + 1) + (xcd - r) * q) + off; }
        const int nig = WGM * nN, gid = wgid / nig, fm = gid * WGM, gsz = (nM - fm) < WGM ? (nM - fm) : WGM, gsh = (gsz == 8) ? 3 : 2, w = wgid - gid * nig;
        u.pm = fm + (w & (gsz - 1)); u.pn = w >> gsh;
#if defined(__HIP_DEVICE_COMPILE__)
        u.pm = __builtin_amdgcn_readfirstlane(u.pm); u.pn = __builtin_amdgcn_readfirstlane(u.pn);
#endif
        return true;
    }
    __device__ __forceinline__ void a_ready(const Unit&) const {}
    __device__ __forceinline__ void done(const Unit&) const {}
};
typedef __bf16 bf16v2 __attribute__((ext_vector_type(2)));
__device__ __forceinline__ unsigned cvt_pk_bf16(float lo, float hi) { const f32x2 v = {lo, hi}; const bf16v2 b = __builtin_convertvector(v, bf16v2); return __builtin_bit_cast(unsigned, b); }
__device__ __forceinline__ f32x2 gelu_pk(f32x2 v) {
    const f32x2 av = __builtin_elementwise_abs(v), d = av * 0.2316418882f + 1.0f;
    f32x2 t; t.x = __builtin_amdgcn_rcpf(d.x); t.y = __builtin_amdgcn_rcpf(d.y);
    f32x2 q = t * 0.5307027145f + (-0.7265760135f); q = q * t + 0.7107068705f; q = q * t + (-0.142248368f); q = q * t + 0.127414796f; q = q * t;
    const f32x2 s = (v * v) * (-0.72134752044f);
    f32x2 e; e.x = __builtin_amdgcn_exp2f(s.x); e.y = __builtin_amdgcn_exp2f(s.y);
    const f32x2 m = v * (q * e), r = v - m;
    f32x2 o; o.x = v.x < 0.f ? m.x : r.x; o.y = v.y < 0.f ? m.y : r.y; return o;
}

template <int ACT, bool COLSUM, bool BLK = false, int sr = 0, int sc = 0, int a_pn = (1 << 30)> struct EpiBf {
    static constexpr bool PERM = true, AFTER_DRAIN = false;
    bf16_t* O; int ldc; float* part; float* abuf;
    const float* qgain; const float* kgain; LAS float* lt;
    __device__ __forceinline__ void operator()(const f32x4 (&acc)[2][2][4][2], const Unit& u, int wr, int wc, int fr, int fq) const {
        const int row0 = u.pm * BM + wr * 64 + fr;
        const bool hn = (ACT == 0) && (qgain != nullptr);
        if (hn) {
#pragma unroll
            for (int ai = 0; ai < 2; ++ai)
#pragma unroll
                for (int m = 0; m < 4; ++m)
#pragma unroll
                    for (int bj = 0; bj < 2; ++bj) { const f32x4 a = acc[ai][bj][m][0], b = acc[ai][bj][m][1];
                        float q = (a[0] * a[0] + a[1] * a[1]) + (a[2] * a[2] + a[3] * a[3]) + (b[0] * b[0] + b[1] * b[1]) + (b[2] * b[2] + b[3] * b[3]);
                        const int ln = fq * 16 + fr;
                        q += __builtin_bit_cast(float, __builtin_amdgcn_ds_bpermute((ln ^ 16) << 2, __builtin_bit_cast(int, q)));
                        q += __builtin_bit_cast(float, __builtin_amdgcn_ds_bpermute((ln ^ 32) << 2, __builtin_bit_cast(int, q)));
                        if (fq == 0) lt[((ai * HALF + wr * 64 + m * 16 + fr) * 2 + bj) * 4 + wc] = q; }
            asm volatile("s_waitcnt lgkmcnt(0)" ::: "memory"); __builtin_amdgcn_s_barrier(); asm volatile("" ::: "memory");
        }
        if (ACT == 0 && u.pn >= a_pn) {
            if (wc == 0 && fq < 2) {
#pragma unroll
                for (int ai = 0; ai < 2; ++ai)
#pragma unroll
                    for (int m = 0; m < 4; ++m) { float* rp = abuf + (size_t)(row0 + ai * HALF + m * 16) * 16 + 8 * fq;
#pragma unroll
                        for (int n = 0; n < 2; ++n) *(f32x4*)(rp + 4 * n) = acc[ai][0][m][n]; }
            }
            return;
        }
        const int col0 = u.pn * BM + wc * 32 + 8 * fq;
        float cs[2][2][4];
#pragma unroll
        for (int bj = 0; bj < 2; ++bj)
#pragma unroll
            for (int n = 0; n < 2; ++n)
#pragma unroll
                for (int e = 0; e < 4; ++e) cs[bj][n][e] = 0.f;
#pragma unroll
        for (int ai = 0; ai < 2; ++ai)
#pragma unroll
            for (int m = 0; m < 4; ++m) { const int row = row0 + ai * HALF + m * 16; const unsigned roff = BLK ? (unsigned)((row >> 6) * sr * 4096 + (row & 63) * 64) : (unsigned)row * (unsigned)ldc + (unsigned)col0;
#pragma unroll
                for (int bj = 0; bj < 2; ++bj) { f32x4 v0 = acc[ai][bj][m][0], v1 = acc[ai][bj][m][1];
                    if (hn) { const int rl = ai * HALF + wr * 64 + m * 16 + fr; const LAS float* pp = lt + (rl * 2 + bj) * 4 + (wc & 2);
                        const float rr = rsqrtf((pp[0] + pp[1]) * (1.f / 64.f) + 1e-6f); const bool isq = u.pn < 4; const int d0 = ((wc & 1) * 32 + 8 * fq);
                        const float* gp = (isq ? qgain : kgain) + d0; const f32x4 ga = *(const f32x4*)gp, gb = *(const f32x4*)(gp + 4);
                        const float sc2 = isq ? rr * (0.125f * 1.4426950408889634f) : rr;
                        v0 = v0 * ga * sc2; v1 = v1 * gb * sc2; }
                    if (ACT == 1) { f32x2 a = gelu_pk((f32x2){v0[0], v0[1]}), b = gelu_pk((f32x2){v0[2], v0[3]}), c = gelu_pk((f32x2){v1[0], v1[1]}), d = gelu_pk((f32x2){v1[2], v1[3]});
                        v0 = (f32x4){a.x, a.y, b.x, b.y}; v1 = (f32x4){c.x, c.y, d.x, d.y}; }
                    else if (ACT == 2) {
#pragma unroll
                        for (int e = 0; e < 4; ++e) { float a = fmaxf(v0[e], 0.f), b = fmaxf(v1[e], 0.f); v0[e] = a * a; v1[e] = b * b; } }
                    if (COLSUM && part) {
#pragma unroll
                        for (int e = 0; e < 4; ++e) { cs[bj][0][e] += v0[e] * v0[e]; cs[bj][1][e] += v1[e] * v1[e]; } }
                    u32x4 w; w.x = cvt_pk_bf16(v0[0], v0[1]); w.y = cvt_pk_bf16(v0[2], v0[3]); w.z = cvt_pk_bf16(v1[0], v1[1]); w.w = cvt_pk_bf16(v1[2], v1[3]);
                    if (BLK) { const int col = col0 + bj * HALF; *(u32x4*)(O + (roff + (unsigned)((col >> 6) * sc * 4096 + (col & 63)))) = w; } else *(u32x4*)(O + (roff + bj * HALF)) = w; }
                asm volatile("" ::: "memory"); }
        if (hn) { asm volatile("s_waitcnt lgkmcnt(0)" ::: "memory"); __builtin_amdgcn_s_barrier(); asm volatile("" ::: "memory"); }
        if (COLSUM && part) {
#pragma unroll
            for (int bj = 0; bj < 2; ++bj)
#pragma unroll
                for (int n = 0; n < 2; ++n)
#pragma unroll
                    for (int e = 0; e < 4; ++e) { float s = cs[bj][n][e];
                        { const int ln = fq * 16 + fr; s += __builtin_bit_cast(float, __builtin_amdgcn_ds_bpermute((ln ^ 1) << 2, __builtin_bit_cast(int, s))); s += __builtin_bit_cast(float, __builtin_amdgcn_ds_bpermute((ln ^ 2) << 2, __builtin_bit_cast(int, s))); s += __builtin_bit_cast(float, __builtin_amdgcn_ds_bpermute((ln ^ 4) << 2, __builtin_bit_cast(int, s))); s += __builtin_bit_cast(float, __builtin_amdgcn_ds_bpermute((ln ^ 8) << 2, __builtin_bit_cast(int, s))); }
                        if (fr == 0) part[(size_t)(col0 + bj * HALF + 4 * n + e) * 24 + u.pm * 2 + wr] = s; }
        }
    }
};
struct EpiResid {
    static constexpr bool PERM = false, AFTER_DRAIN = false;
    const float* xin; float* xout; const float* gate;
    __device__ __forceinline__ void operator()(const f32x4 (&acc)[2][2][4][2], const Unit& u, int wr, int wc, int fr, int fq) const {
        const int row0 = u.pm * BM + wr * 64 + fr, col0 = u.pn * BM + wc * 32 + 4 * fq;
        const float* gp = gate + (size_t)(u.pm >> 5) * 6144 + col0;
#pragma unroll
        for (int bj = 0; bj < 2; ++bj)
#pragma unroll
            for (int n = 0; n < 2; ++n) { const f32x4 gv = *(const f32x4*)(gp + bj * HALF + n * 16);
#pragma unroll
                for (int ai = 0; ai < 2; ++ai)
#pragma unroll
                    for (int m = 0; m < 4; ++m) { const unsigned off = (unsigned)((row0 + ai * HALF + m * 16) * 1024 + col0 + bj * HALF + n * 16);
                        const f32x4 xi = *(const f32x4*)(xin + off); *(f32x4*)(xout + off) = xi + gv * acc[ai][bj][m][n];
                        if (m == 3 && ai == 1 && n == 1) asm volatile("" ::: "memory"); } }
    }
};

__device__ __forceinline__ const char* uni(const char* p) { const unsigned long long v = (unsigned long long)p;
    const unsigned lo = __builtin_amdgcn_readfirstlane((unsigned)v), hi = __builtin_amdgcn_readfirstlane((unsigned)(v >> 32)); return (const char*)(((unsigned long long)hi << 32) | lo); }
template <class Epi, class Sched, bool ALIGN_EPI = false, bool SP2 = false>
__device__ __forceinline__ void gemm_phase(const int tid, LAS unsigned char* lds, const Gemm g, const Sched& S, const Epi& E) {
    const int wid = __builtin_amdgcn_readfirstlane(tid >> 6), lane = tid & 63, wr = wid >> 2, wc = wid & 3, fr = lane & 15, fq = lane >> 4;
    const int K = g.K, nt = K / BK;
    unsigned voffA[2], voffB[2];
#pragma unroll
    for (int i = 0; i < 2; ++i) { int R, C; stage_rc(tid * 16 + i * 8192, R, C); const int Rb = Epi::PERM ? ((R & ~31) + perm32(R & 31)) : R;
        voffA[i] = (unsigned)(R * K + C) * 2u; voffB[i] = (unsigned)(Rb * K + C) * 2u; }
    const size_t kstep = (size_t)(BK * 2);
    const size_t hstep = (size_t)HALF * K * 2;
    const size_t tstep = 2 * hstep;
    const unsigned ldsw = (unsigned)wid * 1024u;
    const int aoff = lds_byte(wr * 64 + fr, fq * 8), boff = lds_byte(wc * 32 + fr, fq * 8);
#define PG8_SA(b, h) (((b) * 2 + (h)) * HTB)
#define PG8_SB(b, h) ((4 + (b) * 2 + (h)) * HTB)
#define PG8_STAGE(bufoff, gbase, voff) do { _Pragma("unroll") for (int _i = 0; _i < 2; ++_i) \
        __builtin_amdgcn_global_load_lds((const unsigned*)((const char*)(gbase) + (voff)[_i]), (LAS unsigned*)(lds + (bufoff) + ldsw + _i * 8192), 16, 0, 0); } while (0)
#define PG8_LDA(dst, b, h) do { _Pragma("unroll") for (int m = 0; m < 4; ++m) _Pragma("unroll") for (int k = 0; k < 2; ++k) dst[m][k] = *(const LAS bf16x8*)(lds + PG8_SA(b, h) + aoff + m * 2048 + k * 1024); } while (0)
#define PG8_LDB(dst, b, h) do { _Pragma("unroll") for (int n = 0; n < 2; ++n) _Pragma("unroll") for (int k = 0; k < 2; ++k) dst[n][k] = *(const LAS bf16x8*)(lds + PG8_SB(b, h) + boff + n * 2048 + k * 1024); } while (0)
#define PG8_MMA(ai, bj, At, Bt) do { __builtin_amdgcn_s_setprio(1); _Pragma("unroll") for (int m = 0; m < 4; ++m) _Pragma("unroll") for (int n = 0; n < 2; ++n) _Pragma("unroll") for (int k = 0; k < 2; ++k) \
        acc[ai][bj][m][n] = __builtin_amdgcn_mfma_f32_16x16x32_bf16(Bt[n][k], At[m][k], acc[ai][bj][m][n], 0, 0, 0); __builtin_amdgcn_s_setprio(0); } while (0)
#define PG8_WAIT_V(n) asm volatile("s_waitcnt vmcnt(" #n ")" ::: "memory")
#define PG8_WAIT_L(n) asm volatile("s_waitcnt lgkmcnt(" #n ")" ::: "memory")
#define PG8_BAR __builtin_amdgcn_s_barrier()
#define PG8_SCHED __builtin_amdgcn_sched_barrier(0)
    Unit cur, nxt; int ui = 0;
    if (!S.next(0, cur)) return;
    f32x4 acc[2][2][4][2];
#pragma unroll
    for (int a = 0; a < 2; ++a)
#pragma unroll
        for (int b = 0; b < 2; ++b)
#pragma unroll
            for (int m = 0; m < 4; ++m)
#pragma unroll
                for (int n = 0; n < 2; ++n) acc[a][b][m][n] = (f32x4){0.f, 0.f, 0.f, 0.f};
    bf16x8 At[4][2], B0[2][2], B1[2][2];
    const char* cA = uni((const char*)g.A + (size_t)cur.pm * tstep); const char* cB = uni((const char*)g.Bt + (size_t)cur.pn * tstep);
    S.a_ready(cur);
    if constexpr (SP2) {
        PG8_STAGE(PG8_SB(0, 0), cB, voffB); PG8_STAGE(PG8_SB(0, 1), cB + hstep, voffB); PG8_STAGE(PG8_SA(0, 0), cA, voffA); PG8_STAGE(PG8_SA(0, 1), cA + hstep, voffA);
        if (wr == 1) PG8_BAR;
        PG8_WAIT_V(2); PG8_BAR;
        PG8_STAGE(PG8_SB(1, 0), cB + kstep, voffB); PG8_STAGE(PG8_SA(1, 0), cA + kstep, voffA); PG8_STAGE(PG8_SB(1, 1), cB + hstep + kstep, voffB);
        PG8_WAIT_V(6); PG8_BAR;
    } else {
        PG8_STAGE(PG8_SB(0, 0), cB, voffB); PG8_STAGE(PG8_SA(0, 0), cA, voffA); PG8_STAGE(PG8_SB(0, 1), cB + hstep, voffB); PG8_STAGE(PG8_SA(0, 1), cA + hstep, voffA);
        if (wr == 1) PG8_BAR;
        PG8_WAIT_V(4); PG8_BAR;
        PG8_STAGE(PG8_SB(1, 0), cB + kstep, voffB); PG8_STAGE(PG8_SA(1, 0), cA + kstep, voffA); PG8_STAGE(PG8_SB(1, 1), cB + hstep + kstep, voffB);
        PG8_WAIT_V(6); PG8_BAR;
    }
    for (;;) {
        const bool has_next = S.next(ui + 1, nxt);
        const char* nA = uni(has_next ? (const char*)g.A + (size_t)nxt.pm * tstep : cA); const char* nB = uni(has_next ? (const char*)g.Bt + (size_t)nxt.pn * tstep : cB);
        for (int t = 0; t < nt; t += 2) {
            const bool last = (t == nt - 2);
            const char* a1 = uni(cA + (size_t)(t + 1) * kstep);
            const char* a2 = uni(last ? nA : cA + (size_t)(t + 2) * kstep); const char* b2 = uni(last ? nB : cB + (size_t)(t + 2) * kstep);
            const char* a3 = a2 + kstep; const char* b3 = b2 + kstep;
            if (last && has_next) S.a_ready(nxt);
            if constexpr (SP2) {
            PG8_LDB(B0, 0, 0); PG8_LDB(B1, 0, 1); PG8_SCHED; PG8_LDA(At, 0, 0); PG8_STAGE(PG8_SA(1, 1), a1 + hstep, voffA);
            PG8_WAIT_V(8); PG8_WAIT_L(0); PG8_BAR; PG8_MMA(0, 0, At, B0); PG8_MMA(0, 1, At, B1); PG8_BAR; PG8_SCHED;
            PG8_LDA(At, 0, 1); PG8_STAGE(PG8_SB(0, 0), b2, voffB); PG8_STAGE(PG8_SB(0, 1), b2 + hstep, voffB); PG8_STAGE(PG8_SA(0, 0), a2, voffA);
            PG8_WAIT_V(8); PG8_WAIT_L(0); PG8_BAR; PG8_MMA(1, 0, At, B0); PG8_MMA(1, 1, At, B1); PG8_BAR; PG8_SCHED;
            PG8_LDB(B0, 1, 0); PG8_LDB(B1, 1, 1); PG8_SCHED; PG8_LDA(At, 1, 0); PG8_STAGE(PG8_SA(0, 1), a2 + hstep, voffA);
            PG8_WAIT_V(8); PG8_WAIT_L(0); PG8_BAR; PG8_MMA(0, 0, At, B0); PG8_MMA(0, 1, At, B1); PG8_BAR; PG8_SCHED;
            PG8_LDA(At, 1, 1); PG8_STAGE(PG8_SB(1, 0), b3, voffB); PG8_STAGE(PG8_SB(1, 1), b3 + hstep, voffB); PG8_STAGE(PG8_SA(1, 0), a3, voffA);
            PG8_WAIT_V(8); PG8_WAIT_L(0); PG8_BAR; PG8_MMA(1, 0, At, B0); PG8_MMA(1, 1, At, B1); PG8_BAR; PG8_SCHED;
            } else {
            PG8_LDB(B0, 0, 0); PG8_SCHED; PG8_LDA(At, 0, 0); PG8_STAGE(PG8_SA(1, 1), a1 + hstep, voffA);
            PG8_WAIT_L(8); PG8_BAR; PG8_WAIT_L(0); PG8_MMA(0, 0, At, B0); PG8_BAR; PG8_SCHED;
            PG8_LDB(B1, 0, 1); PG8_STAGE(PG8_SB(0, 0), b2, voffB);
            PG8_BAR; PG8_WAIT_L(0); PG8_MMA(0, 1, At, B1); PG8_BAR;
            PG8_LDA(At, 0, 1); PG8_STAGE(PG8_SA(0, 0), a2, voffA);
            PG8_BAR; PG8_WAIT_L(0); PG8_MMA(1, 0, At, B0); PG8_BAR; PG8_SCHED;
            PG8_STAGE(PG8_SB(0, 1), b2 + hstep, voffB);
            PG8_WAIT_V(6); PG8_BAR; PG8_MMA(1, 1, At, B1); PG8_BAR;
            PG8_LDB(B0, 1, 0); PG8_SCHED; PG8_LDA(At, 1, 0); PG8_STAGE(PG8_SA(0, 1), a2 + hstep, voffA);
            PG8_WAIT_L(8); PG8_BAR; PG8_WAIT_L(0); PG8_MMA(0, 0, At, B0); PG8_BAR; PG8_SCHED;
            PG8_LDB(B1, 1, 1); PG8_STAGE(PG8_SB(1, 0), b3, voffB);
            PG8_BAR; PG8_WAIT_L(0); PG8_MMA(0, 1, At, B1); PG8_BAR;
            PG8_LDA(At, 1, 1); PG8_STAGE(PG8_SA(1, 0), a3, voffA);
            PG8_BAR; PG8_WAIT_L(0); PG8_MMA(1, 0, At, B0); PG8_BAR; PG8_SCHED;
            PG8_STAGE(PG8_SB(1, 1), b3 + hstep, voffB);
            PG8_WAIT_V(6); PG8_BAR; PG8_MMA(1, 1, At, B1); PG8_BAR;
            }
        }
        if constexpr (ALIGN_EPI) { if (wr == 0) PG8_BAR; }
        { int fr_e = fr, fq_e = fq; asm volatile("" : "+v"(fr_e), "+v"(fq_e));
          E(acc, cur, wr, wc, fr_e, fq_e); } S.done(cur);
        if (!has_next) break;
#pragma unroll
        for (int a = 0; a < 2; ++a)
#pragma unroll
            for (int b = 0; b < 2; ++b)
#pragma unroll
                for (int m = 0; m < 4; ++m)
#pragma unroll
                    for (int n = 0; n < 2; ++n) acc[a][b][m][n] = (f32x4){0.f, 0.f, 0.f, 0.f};
        cur = nxt; cA = nA; cB = nB; ++ui;
        if constexpr (ALIGN_EPI) { if (wr == 1) PG8_BAR; }
    }
    PG8_WAIT_V(0);
    if constexpr (!ALIGN_EPI) { if (wr == 0) PG8_BAR; }
    PG8_BAR;
#undef PG8_SA
#undef PG8_SB
#undef PG8_STAGE
#undef PG8_LDA
#undef PG8_LDB
#undef PG8_MMA
#undef PG8_WAIT_V
#undef PG8_WAIT_L
#undef PG8_BAR
#undef PG8_SCHED
}
}

constexpr int NTOK = 32768, DM = 1024, SEQ = 8192;
constexpr float EPS = 1e-6f;
constexpr size_t MiB = (size_t)1 << 20;
constexpr size_t OFF_MOD = 0;
constexpr size_t OFF_BAR = 512 * 1024;
constexpr size_t OFF_PART = 1 * MiB;
constexpr size_t OFF_ABUF = 1 * MiB;
constexpr size_t OFF_DBUF = 3 * MiB;
constexpr size_t OFF_W = 4 * MiB;
constexpr size_t OFF_H = 111 * MiB;
constexpr size_t OFF_BIG = 175 * MiB;
constexpr size_t WS_NEED = 511 * MiB;
constexpr size_t WA_IN = 0, WA_OUT = 3145728, WB_IN = 4194304, WB_OUT = 10485760, WC_IN = 13631488, WC_OUT = 17039360, WD_IN = 18087936, WD_OUT = 21233664, W_F1 = 22282240, W_F2 = 39059456, W_END = 55836672;
static_assert(OFF_W + W_END * 2 <= OFF_H, "weights overflow");
constexpr size_t B_QK = 0, B_VT = 128 * MiB;
constexpr size_t B_U = 0, B_VTB = 192 * MiB;
constexpr size_t B_DS = 192 * MiB, B_ATT = 320 * MiB;
constexpr size_t B_HID = 0;

constexpr int NSEG = 19;
struct SegTab { int v[NSEG][9]; int nitems; };
constexpr SegTab make_segs() {
    SegTab r{}; int n = 0, items = 0;
    auto add = [&](int in_idx, long src_off, int K, int ldw, int nsrc0, int ncols, long dst_off, int row_off) {
        r.v[n][0] = in_idx; r.v[n][1] = (int)src_off; r.v[n][2] = (int)dst_off; r.v[n][3] = K; r.v[n][4] = ldw; r.v[n][5] = nsrc0; r.v[n][6] = ncols; r.v[n][7] = row_off; r.v[n][8] = items; ++n;
        items += (K / 64) * ((ncols + 31) / 32); };
    add(8, 0, 1024, 3072, 0, 3072, WA_IN, 0);
    add(12, 0, 1024, 1024, 0, 1024, WA_OUT, 0);
    add(13, 0, 1024, 6144, 0, 6144, WB_IN, 0);
    add(17, 0, 3072, 1024, 0, 1024, WB_OUT, 0);
    add(18, 0, 1024, 3088, 0, 1024, WC_IN, 0);
    add(18, 0, 1024, 3088, 2048, 1024, WC_IN, 1024);
    add(18, 0, 1024, 3088, 3072, 16, WC_IN, 2048);
    add(18, 0, 1024, 3088, 1024, 1024, WC_IN, 2304);
    add(22, 0, 1024, 1024, 0, 1024, WC_OUT, 0);
    add(23, 0, 1024, 3072, 0, 3072, WD_IN, 0);
    add(24, 0, 1024, 1024, 0, 1024, WD_OUT, 0);
    for (int l = 0; l < 4; ++l) add(6, (long)l * 4194304, 1024, 4096, 0, 4096, (long)W_F1 + (long)l * 4194304, 0);
    for (int l = 0; l < 4; ++l) add(7, (long)l * 4194304, 4096, 1024, 0, 1024, (long)W_F2 + (long)l * 4194304, 0);
    r.nitems = items; return r;
}
constexpr int NITEMS = make_segs().nitems;
struct Params {
    const float* in[25];
    float* out; unsigned char* ws;
    int ph_lo, ph_hi;
};

#ifndef DBL_MASK
#define DBL_MASK 0
#endif
constexpr int NBASE = 38;
struct PhTab { unsigned char t[2 * NBASE + 64][4]; int n; };
constexpr PhTab make_tab() {
    const unsigned char base[NBASE][4] = {
        {0, 0, 0, 0},
        {1, 0, 0, 0}, {2, 0, 0, 1}, {12, 0, 0, 0}, {4, 0, 0, 0}, {3, 0, 0, 0}, {1, 0, 1, 0}, {10, 0, 1, 0}, {16, 0, 1, 0},
        {1, 1, 0, 0}, {11, 1, 0, 1}, {14, 1, 0, 0}, {5, 1, 0, 0}, {11, 1, 1, 1}, {14, 1, 1, 0}, {5, 1, 1, 0}, {15, 1, 0, 0}, {1, 1, 1, 0}, {10, 1, 1, 0}, {16, 1, 1, 0},
        {1, 2, 0, 0}, {13, 2, 0, 1}, {12, 2, 2, 0}, {6, 2, 0, 0}, {7, 2, 0, 0}, {8, 2, 0, 0}, {3, 2, 0, 0}, {1, 2, 1, 0}, {10, 2, 1, 0}, {16, 2, 1, 0},
        {1, 3, 0, 0}, {2, 3, 0, 1}, {12, 3, 1, 0}, {9, 3, 0, 0}, {3, 3, 0, 0}, {1, 3, 1, 0}, {10, 3, 1, 0}, {16, 3, 1, 0}};
    PhTab r{}; int n = 0;
    for (int i = 0; i < NBASE; ++i) { const int reps = ((DBL_MASK >> base[i][0]) & 1) ? 2 : 1;
        for (int k = 0; k < reps; ++k) { r.t[n][0] = base[i][0]; r.t[n][1] = base[i][1]; r.t[n][2] = base[i][2]; r.t[n][3] = (unsigned char)(((i <= 5) ? 1 : 0) | ((base[i][3] && k == reps - 1) ? 2 : 0)); ++n; } }
#ifdef EXTRA_SYNCS
    for (int k = 0; k < EXTRA_SYNCS; ++k) { r.t[n][0] = 1; r.t[n][1] = 0; r.t[n][2] = 2; r.t[n][3] = 0; ++n; }
#endif
    r.n = n; return r;
}
constexpr int NPHASE = make_tab().n;
__constant__ PhTab PHT = make_tab();

__device__ __forceinline__ unsigned f2bf(float f) { unsigned u = __builtin_bit_cast(unsigned, f); return (u + 0x7fffu + ((u >> 16) & 1u)) >> 16; }
__device__ __forceinline__ unsigned pk2(float lo, float hi) { return f2bf(lo) | (f2bf(hi) << 16); }
__device__ __forceinline__ float bf2f(unsigned short s) { return __uint_as_float(((unsigned)s) << 16); }
__device__ __forceinline__ bf16x8 ldg8(const bf16_t* p) { return *(const bf16x8*)p; }
__device__ __forceinline__ void unpack8(bf16x8 v, float* f) { const u32x4 u = __builtin_bit_cast(u32x4, v);
#pragma unroll
    for (int i = 0; i < 4; ++i) { f[2 * i] = __uint_as_float(u[i] << 16); f[2 * i + 1] = __uint_as_float(u[i] & 0xffff0000u); } }
__device__ __forceinline__ bf16x8 pack8(const float* f) { u32x4 u;
#pragma unroll
    for (int i = 0; i < 4; ++i) u[i] = pg8::cvt_pk_bf16(f[2 * i], f[2 * i + 1]);
    return __builtin_bit_cast(bf16x8, u); }
__device__ __forceinline__ void unpack4(u32x2 u, float* f) { f[0] = __uint_as_float(u.x << 16); f[1] = __uint_as_float(u.x & 0xffff0000u); f[2] = __uint_as_float(u.y << 16); f[3] = __uint_as_float(u.y & 0xffff0000u); }
__device__ __forceinline__ u32x2 pack4(float a, float b, float c, float d) { u32x2 r; r.x = pg8::cvt_pk_bf16(a, b); r.y = pg8::cvt_pk_bf16(c, d); return r; }
__device__ __forceinline__ f32x4 mfma16(bf16x8 a, bf16x8 b, f32x4 c) { return __builtin_amdgcn_mfma_f32_16x16x32_bf16(a, b, c, 0, 0, 0); }
__device__ __forceinline__ float shx(float v, int lane, int mask) { return __builtin_bit_cast(float, __builtin_amdgcn_ds_bpermute((lane ^ mask) << 2, __builtin_bit_cast(int, v))); }

#define LDS_WAIT() asm volatile("s_waitcnt lgkmcnt(0)" ::: "memory")
#define SB0() __builtin_amdgcn_sched_barrier(0)
#define GAS __attribute__((address_space(1)))
#define CAS __attribute__((address_space(4)))
template <class T> __device__ __forceinline__ T* as_global(T* p) { return (T*)(GAS T*)p; }

struct ItemP { const float* src; bf16_t* dst; int K, ld, n0, nc, ro, idx; };
__device__ __forceinline__ void tr_load(const ItemP& q, int lane, float (&wv)[32]) {
    const int nblk = (q.nc + 31) >> 5, kb = q.idx / nblk, nb = q.idx - kb * nblk, k0 = 64 * kb, n0 = 32 * nb;
    const int nn = n0 + (lane & 31); const bool ok = nn < q.nc;
#pragma unroll
    for (int i = 0; i < 32; ++i) { const int kk = 2 * i + (lane >> 5); wv[i] = ok ? q.src[(size_t)(k0 + kk) * q.ld + q.n0 + nn] : 0.f; }
}
__device__ __forceinline__ void tr_store(const ItemP& q, int lane, const float (&wv)[32], LAS float* scr) {
    const int nblk = (q.nc + 31) >> 5, kb = q.idx / nblk, nb = q.idx - kb * nblk, k0 = 64 * kb, n0 = 32 * nb;
#pragma unroll
    for (int i = 0; i < 32; ++i) { const int kk = 2 * i + (lane >> 5); scr[kk * 33 + (lane & 31)] = wv[i]; }
    LDS_WAIT(); asm volatile("" ::: "memory");
    const int c = lane & 7;
#pragma unroll
    for (int j = 0; j < 4; ++j) { const int n = (lane >> 3) + 8 * j; const LAS float* sp = scr + (8 * c) * 33 + n;
        u32x4 o; o.x = pk2(sp[0 * 33], sp[1 * 33]); o.y = pk2(sp[2 * 33], sp[3 * 33]); o.z = pk2(sp[4 * 33], sp[5 * 33]); o.w = pk2(sp[6 * 33], sp[7 * 33]);
        *(u32x4*)(q.dst + (size_t)(q.ro + n0 + n) * q.K + k0 + 8 * c) = o; }
    LDS_WAIT(); asm volatile("" ::: "memory");
}
__device__ __forceinline__ ItemP tr_decode(int it, const CAS Params* pp, unsigned char* ws) {
    constexpr SegTab ST = make_segs();
    int sidx = ST.v[0][0], ssrc = ST.v[0][1], sdst = ST.v[0][2], sK = ST.v[0][3], sld = ST.v[0][4], sn0 = ST.v[0][5], snc = ST.v[0][6], sro = ST.v[0][7], si0 = 0;
#pragma unroll
    for (int q = 1; q < NSEG; ++q) { const bool t = it >= ST.v[q][8];
        sidx = t ? ST.v[q][0] : sidx; ssrc = t ? ST.v[q][1] : ssrc; sdst = t ? ST.v[q][2] : sdst; sK = t ? ST.v[q][3] : sK; sld = t ? ST.v[q][4] : sld; sn0 = t ? ST.v[q][5] : sn0; snc = t ? ST.v[q][6] : snc; sro = t ? ST.v[q][7] : sro; si0 = t ? ST.v[q][8] : si0; }
    const float* src = pp->in[6];
    src = sidx == 7 ? pp->in[7] : src; src = sidx == 8 ? pp->in[8] : src; src = sidx == 12 ? pp->in[12] : src; src = sidx == 13 ? pp->in[13] : src; src = sidx == 17 ? pp->in[17] : src;
    src = sidx == 18 ? pp->in[18] : src; src = sidx == 22 ? pp->in[22] : src; src = sidx == 23 ? pp->in[23] : src; src = sidx == 24 ? pp->in[24] : src;
    ItemP r; r.src = as_global(src) + (size_t)(unsigned)ssrc; r.dst = (bf16_t*)(ws + OFF_W) + (size_t)(unsigned)sdst; r.K = sK; r.ld = sld; r.n0 = sn0; r.nc = snc; r.ro = sro; r.idx = it - si0;
    return r;
}
__device__ __forceinline__ void p0_phase(const int tid, const int bid, const CAS Params* pp, unsigned char* ws, LAS unsigned char* lds) {
    const int lane = tid & 63, wave = __builtin_amdgcn_readfirstlane(tid >> 6), G = gridDim.x;
    float* mod = (float*)(ws + OFF_MOD);
    const float* cin = as_global(pp->in[1]); const float* ada_w = as_global(pp->in[2]); const float* ada_b = as_global(pp->in[3]);
    for (int item = bid; item < 256; item += G) {
        const int L = item >> 6, cgp = item & 63, c4 = lane % 24, kq = lane / 24, k0 = wave * 128;
        f32x4 a0 = {0.f, 0.f, 0.f, 0.f}, a1 = a0, a2 = a0, a3 = a0;
        if (kq < 2) {
            const float* wp = ada_w + ((size_t)L * 1024 + k0 + kq) * 6144 + cgp * 96 + 4 * c4;
#pragma unroll 8
            for (int k = 0; k < 64; ++k) {
                const f32x4 w4 = *(const f32x4*)(wp + (size_t)(2 * k) * 6144);
                const int kk = k0 + kq + 2 * k;
                const float c0 = cin[kk], c1 = cin[1024 + kk], c2 = cin[2048 + kk], c3 = cin[3072 + kk];
                a0 += w4 * (c0 / (1.f + __expf(-c0))); a1 += w4 * (c1 / (1.f + __expf(-c1))); a2 += w4 * (c2 / (1.f + __expf(-c2))); a3 += w4 * (c3 / (1.f + __expf(-c3)));
            }
        }
        LAS float* red = (LAS float*)lds;
        if (kq < 2) { const int kg = wave * 2 + kq;
            *(LAS f32x4*)(red + (kg * 4 + 0) * 96 + 4 * c4) = a0; *(LAS f32x4*)(red + (kg * 4 + 1) * 96 + 4 * c4) = a1;
            *(LAS f32x4*)(red + (kg * 4 + 2) * 96 + 4 * c4) = a2; *(LAS f32x4*)(red + (kg * 4 + 3) * 96 + 4 * c4) = a3; }
        __syncthreads();
        if (tid < 384) { const int b = tid / 96, cc = tid - b * 96; float s = ada_b[L * 6144 + cgp * 96 + cc];
#pragma unroll
            for (int w = 0; w < 16; ++w) s += red[(w * 4 + b) * 96 + cc];
            mod[(size_t)(L * 4 + b) * 6144 + cgp * 96 + cc] = s; }
        __syncthreads();
    }
    LAS float* scr = (LAS float*)(lds + wave * 16384);
    const int gw = bid * 8 + wave, NGW = G * 8;
    for (int it = gw; it < NITEMS; it += 2 * NGW) {
        const int it2 = it + NGW; const bool has2 = it2 < NITEMS;
        const ItemP qa = tr_decode(it, pp, ws), qb = tr_decode(has2 ? it2 : it, pp, ws);
        float wa[32], wb[32];
        tr_load(qa, lane, wa); tr_load(qb, lane, wb);
        SB0();
        tr_store(qa, lane, wa, scr);
        if (has2) tr_store(qb, lane, wb, scr);
    }
}

__device__ __forceinline__ void norm_phase(const int tid, const int bid, const float* x, const float* gain, const float* sh, const float* sc, bf16_t* H) {
    const int lane = tid & 63, wave = __builtin_amdgcn_readfirstlane(tid >> 6);
    const int gw = bid * 8 + wave, NGW = gridDim.x * 8;
    for (int row0 = gw * 4; row0 < NTOK; row0 += NGW * 4) {
        const int b = row0 >> 13;
        f32x4 v[4][4];
#pragma unroll
        for (int r = 0; r < 4; ++r)
#pragma unroll
            for (int j = 0; j < 4; ++j) v[r][j] = *((const f32x4*)(x + (size_t)(row0 + r) * DM) + lane + 64 * j);
        f32x4 gm[4], hh[4];
#pragma unroll
        for (int j = 0; j < 4; ++j) { const f32x4 gn = *((const f32x4*)gain + lane + 64 * j), s4 = *((const f32x4*)(sc + (size_t)b * 6144) + lane + 64 * j); gm[j] = gn * (s4 + 1.f); hh[j] = *((const f32x4*)(sh + (size_t)b * 6144) + lane + 64 * j); }
        SB0();
        float ss[4];
#pragma unroll
        for (int r = 0; r < 4; ++r) { float s = 0.f;
#pragma unroll
            for (int j = 0; j < 4; ++j) s += (v[r][j].x * v[r][j].x + v[r][j].y * v[r][j].y) + (v[r][j].z * v[r][j].z + v[r][j].w * v[r][j].w);
            ss[r] = s; }
#pragma unroll
        for (int o = 1; o < 64; o <<= 1) {
#pragma unroll
            for (int r = 0; r < 4; ++r) ss[r] += shx(ss[r], lane, o); }
#pragma unroll
        for (int r = 0; r < 4; ++r) { const float rr = rsqrtf(ss[r] * (1.f / DM) + EPS);
            u32x2* o8 = (u32x2*)(H + (size_t)(row0 + r) * DM) + lane;
#pragma unroll
            for (int j = 0; j < 4; ++j) { const f32x4 y = v[r][j] * rr * gm[j] + hh[j]; o8[64 * j] = pack4(y.x, y.y, y.z, y.w); } }
    }
}

__device__ __forceinline__ void qknorm_phase(const int tid, const int bid, bf16_t* QK, const float* qgain, const float* kgain) {
    const int lane = tid & 63, wave = __builtin_amdgcn_readfirstlane(tid >> 6), sub = lane >> 3, c8 = lane & 7;
    const int gw = bid * 8 + wave, NGW = gridDim.x * 8;
    float qg[8], kg[8];
#pragma unroll
    for (int x = 0; x < 8; ++x) { qg[x] = qgain[8 * c8 + x] * (0.125f * 1.4426950408889634f)  ; kg[x] = kgain[8 * c8 + x]; }
    for (int it = gw; it < 32768; it += NGW) {
        bf16x8 v[4];
#pragma unroll
        for (int u = 0; u < 4; ++u) v[u] = ldg8(QK + ((size_t)it * 32 + u * 8 + sub) * 64 + 8 * c8);
#pragma unroll
        for (int u = 0; u < 4; ++u) { float f[8]; unpack8(v[u], f); float ss = 0.f;
#pragma unroll
            for (int x = 0; x < 8; ++x) ss += f[x] * f[x];
            ss += shx(ss, lane, 1); ss += shx(ss, lane, 2); ss += shx(ss, lane, 4);
            const float r = rsqrtf(ss * (1.f / 64.f) + EPS); const bool isq = it < 16384;
#pragma unroll
            for (int x = 0; x < 8; ++x) f[x] *= r * (isq ? qg[x] : kg[x]);
            *(bf16x8*)(QK + ((size_t)it * 32 + u * 8 + sub) * 64 + 8 * c8) = pack8(f); }
    }
}
__device__ __forceinline__ void load_kfrag(bf16x8 (&kf)[8], const bf16_t* kbase  ) {
#pragma unroll
    for (int c2 = 0; c2 < 2; ++c2)
#pragma unroll
        for (int e = 0; e < 2; ++e) { const bf16_t* kp = kbase + (32 * c2 + 4 * e) * 64; kf[(c2 * 2 + e) * 2] = ldg8(kp); kf[(c2 * 2 + e) * 2 + 1] = ldg8(kp + 32); }
}
__device__ __forceinline__ void load_vfrag(bf16x8 (&vf)[8], const bf16_t* vbase  ) {
#pragma unroll
    for (int c2 = 0; c2 < 2; ++c2)
#pragma unroll
        for (int dt = 0; dt < 4; ++dt) vf[c2 * 4 + dt] = ldg8(vbase + dt * 16 * 64 + 32 * c2);
}
__device__ __forceinline__ void attn_a_phase(const int tid, const int bid, LAS unsigned char* lds, const bf16_t* QK, const bf16_t* VT, bf16_t* O, const float* relb) {
    const int lane = tid & 63, wave = __builtin_amdgcn_readfirstlane(tid >> 6), j = lane & 15, g = lane >> 4;
    const int gw = bid * 8 + wave, NGW = gridDim.x * 8;
    const int klane = (8 * (j >> 2) + (j & 3)) * 64 + 8 * g, vlane = j * 64 + 8 * g;
    for (int id = gw; id < 16384; id += NGW) {
        const int qt2 = id & 1, h = (id >> 1) & 15, ci = (id >> 5) & 127, b = id >> 12;
        const int tq0 = ci * 64 + qt2 * 32 + j;
        const size_t tokq = (size_t)b * SEQ + tq0;
        bf16x8 qb[2][2];
        { const bf16_t* qp = QK + ((size_t)(h * 512) + (tokq >> 6)) * 4096 + (tokq & 63) * 64 + 8 * g; qb[0][0] = ldg8(qp); qb[0][1] = ldg8(qp + 32); qb[1][0] = ldg8(qp + 16 * 64); qb[1][1] = ldg8(qp + 16 * 64 + 32); }
        float m_run[2] = {-INFINITY, -INFINITY}, l_run[2] = {0.f, 0.f};
        f32x4 o[2][4];
#pragma unroll
        for (int qs = 0; qs < 2; ++qs)
#pragma unroll
            for (int dt = 0; dt < 4; ++dt) o[qs][dt] = (f32x4){0.f, 0.f, 0.f, 0.f};
        LAS float* tb = (LAS float*)(lds + wave * 2048);
#pragma unroll
        for (int i = 0; i < 5; ++i) tb[lane + 64 * i] = relb[h * 320 + lane + 64 * i] * 1.4426950408889634f;
        const float bc = relb[h * 320 + 319] * 1.4426950408889634f;
        const int kt_lo = ci > 8 ? ci - 8 : 0;
        const bf16_t* kblk = QK + ((size_t)((16 + h) * 512) + b * 128) * 4096 + klane;
        const bf16_t* vblk = VT + ((size_t)(h * 512) + b * 128) * 4096 + vlane;
        bf16x8 kf[8]; load_kfrag(kf, kblk + (size_t)kt_lo * 4096);
        asm volatile("" :: "v"(kf[0]), "v"(kf[1]), "v"(kf[2]), "v"(kf[3]), "v"(kf[4]), "v"(kf[5]), "v"(kf[6]), "v"(kf[7]));
        for (int kt = kt_lo; kt <= ci; ++kt) {
            bf16x8 vf[8], kn[8];
            load_vfrag(vf, vblk + (size_t)kt * 4096);
            load_kfrag(kn, kblk + (size_t)(kt < ci ? kt + 1 : kt) * 4096);
            SB0();
            f32x4 sq[2][2][2];
#pragma unroll
            for (int qs = 0; qs < 2; ++qs)
#pragma unroll
                for (int c2 = 0; c2 < 2; ++c2)
#pragma unroll
                    for (int e = 0; e < 2; ++e) { f32x4 a = mfma16(kf[(c2 * 2 + e) * 2], qb[qs][0], (f32x4){0.f, 0.f, 0.f, 0.f}); sq[qs][c2][e] = mfma16(kf[(c2 * 2 + e) * 2 + 1], qb[qs][1], a); }
            const bool cbias = (ci - kt >= 5);
#pragma unroll
            for (int qs = 0; qs < 2; ++qs) {
                float tmax = -INFINITY;
                if (!cbias) { const int i0 = tq0 + 16 * qs - (kt * 64 + 8 * g) + 63;
#pragma unroll
                    for (int c2 = 0; c2 < 2; ++c2)
#pragma unroll
                        for (int x = 0; x < 8; ++x) { const int ix = i0 - 32 * c2 - x; sq[qs][c2][x >> 2][x & 3] += tb[ix > 319 ? 319 : ix]; }
                } else {
#pragma unroll
                    for (int c2 = 0; c2 < 2; ++c2)
#pragma unroll
                        for (int x = 0; x < 8; ++x) sq[qs][c2][x >> 2][x & 3] += bc; }
#pragma unroll
                for (int c2 = 0; c2 < 2; ++c2)
#pragma unroll
                    for (int x = 0; x < 8; ++x) tmax = fmaxf(tmax, sq[qs][c2][x >> 2][x & 3]);
                tmax = fmaxf(tmax, shx(tmax, lane, 16)); tmax = fmaxf(tmax, shx(tmax, lane, 32));
                const float m_new = fmaxf(m_run[qs], tmax), alpha = __builtin_amdgcn_exp2f(m_run[qs] - m_new);
                float lsum = 0.f; float pf[2][8];
#pragma unroll
                for (int c2 = 0; c2 < 2; ++c2)
#pragma unroll
                    for (int x = 0; x < 8; ++x) { const float pv = __builtin_amdgcn_exp2f(sq[qs][c2][x >> 2][x & 3] - m_new); pf[c2][x] = pv; lsum += pv; }
                l_run[qs] = l_run[qs] * alpha + lsum; m_run[qs] = m_new;
#pragma unroll
                for (int dt = 0; dt < 4; ++dt) o[qs][dt] *= alpha;
#pragma unroll
                for (int c2 = 0; c2 < 2; ++c2) { const bf16x8 pb = pack8(pf[c2]);
#pragma unroll
                    for (int dt = 0; dt < 4; ++dt) o[qs][dt] = mfma16(vf[c2 * 4 + dt], pb, o[qs][dt]); }
            }
            SB0();
            asm volatile("" :: "v"(kn[0]), "v"(kn[1]), "v"(kn[2]), "v"(kn[3]), "v"(kn[4]), "v"(kn[5]), "v"(kn[6]), "v"(kn[7]));
#pragma unroll
            for (int x = 0; x < 8; ++x) kf[x] = kn[x];
        }
#pragma unroll
        for (int qs = 0; qs < 2; ++qs) {
            float l = l_run[qs]; l += shx(l, lane, 16); l += shx(l, lane, 32);
            const float inv = 1.f / l;
#pragma unroll
            for (int dt = 0; dt < 4; ++dt) *(u32x2*)(O + (tokq + 16 * qs) * 1024 + h * 64 + dt * 16 + 4 * g) = pack4(o[qs][dt][0] * inv, o[qs][dt][1] * inv, o[qs][dt][2] * inv, o[qs][dt][3] * inv);
        }
    }
}

__device__ __forceinline__ void attn_d_phase(const int tid, const int bid, const bf16_t* QK, const bf16_t* VT, bf16_t* O) {
    const int lane = tid & 63, wave = __builtin_amdgcn_readfirstlane(tid >> 6), j = lane & 15, g = lane >> 4;
    const int gw = bid * 8 + wave, NGW = gridDim.x * 8;
    const int klane = (8 * (j >> 2) + (j & 3)) * 64 + 8 * g, vlane = j * 64 + 8 * g;
    for (int id = gw; id < 16384; id += NGW) {
        const int qt32 = id & 255, h = (id >> 8) & 15, b = id >> 12;
        const int tq0 = qt32 * 32 + j;
        const size_t tokq = (size_t)b * SEQ + tq0;
        const bf16_t* qp = QK + ((size_t)(h * 512) + (tokq >> 6)) * 4096 + (tokq & 63) * 64 + 8 * g;
        bf16x8 qb[2][2];
        qb[0][0] = ldg8(qp); qb[0][1] = ldg8(qp + 32); qb[1][0] = ldg8(qp + 16 * 64); qb[1][1] = ldg8(qp + 16 * 64 + 32);
        float carry[2] = {0.f, 0.f};
        f32x4 o[2][4];
#pragma unroll
        for (int qs = 0; qs < 2; ++qs)
#pragma unroll
            for (int dt = 0; dt < 4; ++dt) o[qs][dt] = (f32x4){0.f, 0.f, 0.f, 0.f};
        const bf16_t* kblk = QK + ((size_t)((16 + h) * 512) + b * 128) * 4096 + klane;
        const bf16_t* vblk = VT + ((size_t)(h * 512) + b * 128) * 4096 + vlane;
        const int kt0 = (qt32 * 32 + 31) >> 6;
        bf16x8 kf[8]; load_kfrag(kf, kblk + (size_t)kt0 * 4096);
        asm volatile("" :: "v"(kf[0]), "v"(kf[1]), "v"(kf[2]), "v"(kf[3]), "v"(kf[4]), "v"(kf[5]), "v"(kf[6]), "v"(kf[7]));
        for (int kt = kt0; kt >= 0; --kt) {
            bf16x8 vf[8], kn[8];
            load_vfrag(vf, vblk + (size_t)kt * 4096);
            load_kfrag(kn, kblk + (size_t)(kt > 0 ? kt - 1 : 0) * 4096);
            SB0();
            f32x4 sq[2][2][2];
#pragma unroll
            for (int qs = 0; qs < 2; ++qs)
#pragma unroll
                for (int c2 = 0; c2 < 2; ++c2)
#pragma unroll
                    for (int e = 0; e < 2; ++e) { f32x4 a = mfma16(kf[(c2 * 2 + e) * 2], qb[qs][0], (f32x4){0.f, 0.f, 0.f, 0.f}); sq[qs][c2][e] = mfma16(kf[(c2 * 2 + e) * 2 + 1], qb[qs][1], a); }
#pragma unroll
            for (int qs = 0; qs < 2; ++qs) {
                const int tq = tq0 + 16 * qs;
                float ln[2][8], ls[2][8], E[2][8], C[2], Gs[2];
#pragma unroll
                for (int c2 = 0; c2 < 2; ++c2)
#pragma unroll
                    for (int x = 0; x < 8; ++x) {
                        const float z = sq[qs][c2][x >> 2][x & 3] * (0.125f * 1.4426950408889634f);
                        const bool valid = (kt * 64 + 32 * c2 + 8 * g + x) < tq;
                        const float sp = fmaxf(z, 0.f) + __builtin_amdgcn_logf(1.f + __builtin_amdgcn_exp2f(-fabsf(z)));
                        ln[c2][x] = valid ? -sp : 0.f;
                        ls[c2][x] = valid ? (z - sp) : -INFINITY;
                    }
#pragma unroll
                for (int c2 = 0; c2 < 2; ++c2) { float run = 0.f;
#pragma unroll
                    for (int x = 7; x >= 0; --x) { E[c2][x] = run; run += ln[c2][x]; }
                    const float t1 = shx(run, lane, 16), t2 = shx(run, lane, 32), t3 = shx(run, lane, 48);
                    C[c2] = (run + t1) + (t2 + t3);
                    Gs[c2] = (((g ^ 1) > g) ? t1 : 0.f) + (((g ^ 2) > g) ? t2 : 0.f) + (((g ^ 3) > g) ? t3 : 0.f);
                }
                const float base1 = carry[qs] + Gs[1], base0 = carry[qs] + C[1] + Gs[0];
                float pf[2][8];
#pragma unroll
                for (int x = 0; x < 8; ++x) { pf[1][x] = __builtin_amdgcn_exp2f(ls[1][x] + E[1][x] + base1); pf[0][x] = __builtin_amdgcn_exp2f(ls[0][x] + E[0][x] + base0); }
                carry[qs] += C[0] + C[1];
#pragma unroll
                for (int c2 = 0; c2 < 2; ++c2) { const bf16x8 pb = pack8(pf[c2]);
#pragma unroll
                    for (int dt = 0; dt < 4; ++dt) o[qs][dt] = mfma16(vf[c2 * 4 + dt], pb, o[qs][dt]); }
            }
            SB0();
            asm volatile("" :: "v"(kn[0]), "v"(kn[1]), "v"(kn[2]), "v"(kn[3]), "v"(kn[4]), "v"(kn[5]), "v"(kn[6]), "v"(kn[7]));
#pragma unroll
            for (int x = 0; x < 8; ++x) kf[x] = kn[x];
            if (__all(fmaxf(carry[0], carry[1]) < -150.1f)) break;
        }
#pragma unroll
        for (int qs = 0; qs < 2; ++qs)
#pragma unroll
            for (int dt = 0; dt < 4; ++dt) *(u32x2*)(O + (tokq + 16 * qs) * 1024 + h * 64 + dt * 16 + 4 * g) = pack4(o[qs][dt][0], o[qs][dt][1], o[qs][dt][2], o[qs][dt][3]);
    }
}

__device__ __forceinline__ void b_p2_phase(const int tid, const int bid, LAS unsigned char* lds, int half, bf16_t* U, const bf16_t* VTB, const float* part, const float* w_s, const float* b_s, const float* v_gain) {
    const int lane = tid & 63, wave = __builtin_amdgcn_readfirstlane(tid >> 6), j = lane & 15, g = lane >> 4;
    LAS bf16_t* sW = (LAS bf16_t*)lds;
    LAS float* sR = (LAS float*)(lds + 34816);
    for (int unit = bid; unit < 1024; unit += gridDim.x) {
        const int w = unit >> 3, grp = unit & 7, wtok0 = w * 128;
        if (tid < 128) { const float* pp = part + (size_t)(wtok0 + tid) * 24; float s = 0.f;
#pragma unroll
            for (int q = 0; q < 24; ++q) s += pp[q];
            sR[tid] = rsqrtf(s * (1.f / 3072.f) + EPS); }
        __syncthreads();
#pragma unroll 8
        for (int idx = tid; idx < 16384; idx += 512) { const int i = idx >> 7, jj = idx & 127;
            const float val = ((i >> 6) >= (jj >> 6)) ? w_s[(size_t)(grp * 128 + i) * 128 + jj] * sR[jj] : 0.f;
            sW[i * 136 + jj] = (bf16_t)f2bf(val); }
        __syncthreads();
#pragma unroll 1
        for (int ct = wave; ct < 24; ct += 8) {
            f32x4 acc[8];
#pragma unroll
            for (int it = 0; it < 8; ++it) acc[it] = (f32x4){0.f, 0.f, 0.f, 0.f};
#pragma unroll
            for (int c4 = 0; c4 < 4; ++c4) {
                const int vrow = grp * 384 + ct * 16 + j; const bf16x8 va = ldg8(VTB + ((size_t)(vrow >> 6) * 256 + (wtok0 >> 6) + (c4 >> 1)) * 4096 + (vrow & 63) * 64 + 32 * (c4 & 1) + 8 * g);
#pragma unroll
                for (int it = 0; it < 8; ++it) { const bf16x8 wb = *(const LAS bf16x8*)(sW + (it * 16 + j) * 136 + 32 * c4 + 8 * g); acc[it] = mfma16(va, wb, acc[it]); }
            }
            const int ch0 = grp * 384 + ct * 16 + 4 * g;
            const f32x4 gn = *(const f32x4*)(v_gain + ch0);
#pragma unroll
            for (int it = 0; it < 8; ++it) { const int io = it * 16 + j; const float bs = b_s[grp * 128 + io];
                u32x2* up = (u32x2*)(U + ((size_t)half * 16384 + wtok0 + io) * 3072 + ch0); float uf[4]; unpack4(*up, uf);
                *up = pack4(uf[0] * (acc[it][0] * gn[0] + bs), uf[1] * (acc[it][1] * gn[1] + bs), uf[2] * (acc[it][2] * gn[2] + bs), uf[3] * (acc[it][3] * gn[3] + bs)); }
        }
        __syncthreads();
    }
}

__device__ __forceinline__ void c_p1_phase(const int tid, const int bid, LAS unsigned char* lds, bf16_t* QKR, const bf16_t* VT, const float* abuf, float* dbuf, bf16_t* ATT, bf16_t* DS, const float* wgate, const float* bgate) {
    const int lane = tid & 63, wave = __builtin_amdgcn_readfirstlane(tid >> 6), j = lane & 15, g = lane >> 4;
    LAS bf16_t* sQ = (LAS bf16_t*)lds;
    LAS bf16_t* sK = (LAS bf16_t*)(lds + 17408);
    LAS bf16_t* sKd = (LAS bf16_t*)(lds + 34816);
    LAS float* sA = (LAS float*)(lds + 53248);
    LAS float* sSeg = (LAS float*)(lds + 57344);
    const int kch = tid & 127, seg = tid >> 7;
    for (int unit = bid; unit < 2048; unit += gridDim.x) {
        const int c = unit & 127, h = (unit >> 7) & 3, b = unit >> 9;
        const size_t tok0 = (size_t)b * SEQ + (size_t)c * 64;
        for (int idx = tid; idx < 1024; idx += 512) sA[idx] = abuf[tok0 * 16 + idx];
        float wv[16];
#pragma unroll
        for (int r = 0; r < 16; ++r) wv[r] = wgate[r * 512 + h * 128 + kch];
        const float bg = bgate[h * 128 + kch];
        __syncthreads();
        float cum[16]; float run = 0.f;
#pragma unroll
        for (int i = 0; i < 16; ++i) { const int s = seg * 16 + i; float x = bg;
#pragma unroll
            for (int r = 0; r < 16; ++r) x += sA[s * 16 + r] * wv[r];
            const float la = -(fmaxf(-x, 0.f) + __logf(1.f + __expf(-fabsf(x)))) * (1.f / 16.f);
            run += la; cum[i] = run; }
        sSeg[seg * 128 + kch] = run;
        __syncthreads();
        const float s0 = sSeg[kch], s1 = sSeg[128 + kch], s2 = sSeg[256 + kch], s3 = sSeg[384 + kch];
        const float pre = (seg > 0 ? s0 : 0.f) + (seg > 1 ? s1 : 0.f) + (seg > 2 ? s2 : 0.f), blast = (s0 + s1) + (s2 + s3);
#pragma unroll
        for (int i = 0; i < 16; ++i) { const int s = seg * 16 + i; const float bb = pre + cum[i];
            bf16_t* qp = QKR + ((size_t)((2 * h + (kch >> 6)) * 512) + (tok0 >> 6)) * 4096 + s * 64 + (kch & 63);
            const float qv = bf2f(qp[0]), kv = bf2f(qp[(size_t)8 * 512 * 4096]);
            const bf16_t qb = (bf16_t)f2bf(qv * __expf(bb) * 0.08838834764831845f);
            qp[0] = qb; sQ[s * 136 + kch] = qb; sK[s * 136 + kch] = (bf16_t)f2bf(kv * __expf(-bb)); sKd[kch * 72 + s] = (bf16_t)f2bf(kv * __expf(blast - bb)); }
        if (seg == 0) dbuf[(size_t)unit * 128 + kch] = __expf(blast);
        __syncthreads();
        for (int tl = wave; tl < 16; tl += 8) { const int ti = tl >> 2, si = tl & 3;
            f32x4 a = (f32x4){0.f, 0.f, 0.f, 0.f};
            if (si <= ti) {
#pragma unroll
                for (int c4 = 0; c4 < 4; ++c4) { const bf16x8 ka = *(const LAS bf16x8*)(sK + (si * 16 + j) * 136 + 32 * c4 + 8 * g), qb = *(const LAS bf16x8*)(sQ + (ti * 16 + j) * 136 + 32 * c4 + 8 * g); a = mfma16(ka, qb, a); } }
            const int tt = ti * 16 + j, sb = si * 16 + 4 * g;
            *(u32x2*)(ATT + ((size_t)unit * 64 + tt) * 64 + sb) = pack4(sb + 0 <= tt ? a[0] : 0.f, sb + 1 <= tt ? a[1] : 0.f, sb + 2 <= tt ? a[2] : 0.f, sb + 3 <= tt ? a[3] : 0.f); }
        f32x4 acc[2][8];
#pragma unroll
        for (int vv = 0; vv < 2; ++vv)
#pragma unroll
            for (int kt = 0; kt < 8; ++kt) acc[vv][kt] = (f32x4){0.f, 0.f, 0.f, 0.f};
#pragma unroll
        for (int c2 = 0; c2 < 2; ++c2) { bf16x8 vb[2];
#pragma unroll
            for (int vv = 0; vv < 2; ++vv) { const int vrow = h * 256 + (2 * wave + vv) * 16 + j; vb[vv] = ldg8(VT + ((size_t)(vrow >> 6) * 512 + (tok0 >> 6)) * 4096 + (vrow & 63) * 64 + 32 * c2 + 8 * g); }
#pragma unroll
            for (int kt = 0; kt < 8; ++kt) { const bf16x8 ka = *(const LAS bf16x8*)(sKd + (kt * 16 + j) * 72 + 32 * c2 + 8 * g);
#pragma unroll
                for (int vv = 0; vv < 2; ++vv) acc[vv][kt] = mfma16(ka, vb[vv], acc[vv][kt]); } }
#pragma unroll
        for (int vv = 0; vv < 2; ++vv)
#pragma unroll
            for (int kt = 0; kt < 8; ++kt) *(u32x2*)(DS + ((size_t)unit * 256 + (2 * wave + vv) * 16 + j) * 128 + kt * 16 + 4 * g) = pack4(acc[vv][kt][0], acc[vv][kt][1], acc[vv][kt][2], acc[vv][kt][3]);
        __syncthreads();
    }
}
__device__ __forceinline__ void c_p2_phase(const int tid, const int bid, bf16_t* DS, const float* dbuf) {
    for (int item = bid * 512 + tid; item < 131072; item += gridDim.x * 512) {
        const int bh = item >> 13, e4 = (item & 8191) * 4, kch = e4 & 127;
        float S0 = 0.f, S1 = 0.f, S2 = 0.f, S3 = 0.f;
        for (int c0 = 0; c0 < 128; c0 += 16) {
            u32x2 dv[16]; f32x4 dd[16];
#pragma unroll
            for (int u = 0; u < 16; ++u) { const size_t unit = (size_t)bh * 128 + c0 + u; dv[u] = *(const u32x2*)(DS + unit * 32768 + e4); dd[u] = *(const f32x4*)(dbuf + unit * 128 + kch); }
#pragma unroll
            for (int u = 0; u < 16; ++u) { const size_t unit = (size_t)bh * 128 + c0 + u; float f[4]; unpack4(dv[u], f);
                *(u32x2*)(DS + unit * 32768 + e4) = pack4(S0, S1, S2, S3);
                S0 = S0 * dd[u][0] + f[0]; S1 = S1 * dd[u][1] + f[1]; S2 = S2 * dd[u][2] + f[2]; S3 = S3 * dd[u][3] + f[3]; }
        }
    }
}
__device__ __forceinline__ void c_p3_phase(const int tid, const int bid, const bf16_t* QKR, const bf16_t* VT, const bf16_t* ATT, const bf16_t* DS, bf16_t* O, const float* ogain) {
    const int lane = tid & 63, wave = __builtin_amdgcn_readfirstlane(tid >> 6), j = lane & 15, g = lane >> 4;
    const int gw = bid * 8 + wave, NGW = gridDim.x * 8;
    for (int id = gw; id < 4096; id += NGW) {
        const int tq2 = id & 1, unit = id >> 1, c = unit & 127, h = (unit >> 7) & 3, b = unit >> 9;
        const size_t tok0 = (size_t)b * SEQ + (size_t)c * 64;
        f32x4 acc[2][16];
#pragma unroll
        for (int qs = 0; qs < 2; ++qs)
#pragma unroll
            for (int vt = 0; vt < 16; ++vt) acc[qs][vt] = (f32x4){0.f, 0.f, 0.f, 0.f};
        if (c > 0) {
#pragma unroll 1
            for (int kc = 0; kc < 4; ++kc) {
                const bf16_t* qp = QKR + ((size_t)((2 * h + (kc >> 1)) * 512) + (tok0 >> 6)) * 4096 + (tq2 * 32 + j) * 64 + 32 * (kc & 1) + 8 * g;
                const bf16x8 qb0 = ldg8(qp), qb1 = ldg8(qp + 16 * 64);
#pragma unroll
                for (int vh = 0; vh < 2; ++vh) {
                    bf16x8 sa[8];
#pragma unroll
                    for (int v8 = 0; v8 < 8; ++v8) sa[v8] = ldg8(DS + ((size_t)unit * 256 + (vh * 8 + v8) * 16 + j) * 128 + 32 * kc + 8 * g);
                    SB0();
#pragma unroll
                    for (int v8 = 0; v8 < 8; ++v8) { acc[0][vh * 8 + v8] = mfma16(sa[v8], qb0, acc[0][vh * 8 + v8]); acc[1][vh * 8 + v8] = mfma16(sa[v8], qb1, acc[1][vh * 8 + v8]); }
                    SB0(); } }
        }
#pragma unroll 1
        for (int sc = 0; sc < 2; ++sc) {
            const bf16_t* ap = ATT + ((size_t)unit * 64 + tq2 * 32 + j) * 64 + 32 * sc + 8 * g;
            const bf16x8 ab0 = ldg8(ap), ab1 = ldg8(ap + 16 * 64);
#pragma unroll
            for (int vh = 0; vh < 2; ++vh) {
                bf16x8 va[8];
#pragma unroll
                for (int v8 = 0; v8 < 8; ++v8) { const int vt = vh * 8 + v8; va[v8] = ldg8(VT + ((size_t)((4 * h + (vt >> 2)) * 512) + (tok0 >> 6)) * 4096 + ((vt & 3) * 16 + j) * 64 + 32 * sc + 8 * g); }
                SB0();
#pragma unroll
                for (int v8 = 0; v8 < 8; ++v8) { acc[0][vh * 8 + v8] = mfma16(va[v8], ab0, acc[0][vh * 8 + v8]); acc[1][vh * 8 + v8] = mfma16(va[v8], ab1, acc[1][vh * 8 + v8]); }
                SB0(); } }
#pragma unroll
        for (int qs = 0; qs < 2; ++qs) {
            const size_t tok = tok0 + tq2 * 32 + qs * 16 + j;
            float ss = 0.f;
#pragma unroll
            for (int vt = 0; vt < 16; ++vt) ss += (acc[qs][vt][0] * acc[qs][vt][0] + acc[qs][vt][1] * acc[qs][vt][1]) + (acc[qs][vt][2] * acc[qs][vt][2] + acc[qs][vt][3] * acc[qs][vt][3]);
            ss += shx(ss, lane, 16); ss += shx(ss, lane, 32);
            const float rs = rsqrtf(ss * (1.f / 256.f) + EPS);
#pragma unroll
            for (int vt = 0; vt < 16; ++vt) { const int v0 = vt * 16 + 4 * g;
                float rf[4]; unpack4(*(const u32x2*)(QKR + ((size_t)((16 + 4 * h + (vt >> 2)) * 512) + (tok0 >> 6)) * 4096 + (tq2 * 32 + qs * 16 + j) * 64 + (v0 & 63)), rf);
                const f32x4 og = *(const f32x4*)(ogain + v0);
                float ov[4];
#pragma unroll
                for (int e = 0; e < 4; ++e) ov[e] = acc[qs][vt][e] * rs * og[e] * (rf[e] / (1.f + __expf(-rf[e])));
                *(u32x2*)(O + tok * 1024 + h * 256 + v0) = pack4(ov[0], ov[1], ov[2], ov[3]); }
        }
    }
}

#define XB_TMO      128
#define XB_XCNT(j)  (256  + 64 * (j))
#define XB_XSUB(j)  (1280 + 64 * (j))
#define XB_XGEN(j)  (2304 + 64 * (j))
#define XB_TOP      3328
#define XB_TOPGEN   3392
#define XCD_BAR_WORDS 3456
#define XB_SPIN_CAP (1u << 18)
__device__ __forceinline__ unsigned xb_ld(unsigned* p)              { return __hip_atomic_load(p, __ATOMIC_RELAXED, __HIP_MEMORY_SCOPE_AGENT); }
__device__ __forceinline__ unsigned xb_add(unsigned* p, unsigned v) { return __hip_atomic_fetch_add(p, v, __ATOMIC_RELAXED, __HIP_MEMORY_SCOPE_AGENT); }
__device__ __forceinline__ unsigned xb_xcc_id() { return (unsigned)__builtin_amdgcn_s_getreg((3 << 11) | 20) & 0xFu; }
#define XB_SPIN(cond, bar) do { unsigned _sp = 0; while (cond) { __builtin_amdgcn_s_sleep(1); \
    if ((++_sp & 255u) == 0u) { if (xb_ld(&(bar)[XB_TMO])) break; if (_sp > XB_SPIN_CAP) { atomicAdd(&(bar)[XB_TMO], 1u); break; } } } } while (0)
__device__ __forceinline__ void xcd_barrier_complete(unsigned* bar, unsigned x, unsigned& nloc, unsigned& nx) {
    const unsigned G = gridDim.x * gridDim.y * gridDim.z;
    unsigned sum, cnt, mine, sp = 0u;
    for (;;) {
        sum = 0u; cnt = 0u; mine = 0u;
#pragma unroll
        for (unsigned j = 0; j < 16; ++j) { const unsigned c = xb_ld(&bar[XB_XCNT(j)]); sum += c; cnt += (c > 0u) ? 1u : 0u; mine = (j == x) ? c : mine; }
        if (sum == G) break;
        __builtin_amdgcn_s_sleep(1);
        if ((++sp & 255u) == 0u) { if (xb_ld(&bar[XB_TMO])) break; if (sp > XB_SPIN_CAP) { atomicAdd(&bar[XB_TMO], 1u); break; } }
    }
    nloc = mine > 0u ? mine : 1u; nx = cnt > 0u ? cnt : 1u;
}
__device__ __forceinline__ void xcd_barrier(unsigned* bar, volatile LAS unsigned* st) {
    asm volatile("s_waitcnt vmcnt(0)" ::: "memory");
    __syncthreads();
    if (threadIdx.x == 0) {
        const unsigned x = xb_xcc_id();
        __builtin_amdgcn_s_waitcnt(0);
        unsigned nloc = st[0], nx = st[1];
        if (nloc == 0u) { xcd_barrier_complete(bar, x, nloc, nx); st[0] = nloc; st[1] = nx; }
        const unsigned old = xb_add(&bar[XB_XSUB(x)], 1u);
        const unsigned gen = old / nloc;
        if (old + 1u == (gen + 1u) * nloc) {
            __builtin_amdgcn_fence(__ATOMIC_RELEASE, "agent");
            asm volatile("s_waitcnt vmcnt(0)" ::: "memory");
            const unsigned og = xb_add(&bar[XB_TOP], 1u);
            const unsigned tg = og / nx;
            if (og + 1u == (tg + 1u) * nx) xb_add(&bar[XB_TOPGEN], 1u);
            else XB_SPIN(xb_ld(&bar[XB_TOPGEN]) == tg, bar);
            __builtin_amdgcn_fence(__ATOMIC_ACQUIRE, "agent");
            xb_add(&bar[XB_XGEN(x)], 1u);
            asm volatile("s_waitcnt vmcnt(0)" ::: "memory");
        } else {
            XB_SPIN(xb_ld(&bar[XB_XGEN(x)]) == gen, bar);
            __builtin_amdgcn_fence(__ATOMIC_ACQUIRE, "agent");
            asm volatile("s_waitcnt vmcnt(0)" ::: "memory");
        }
    }
    __syncthreads();
}
constexpr int LDS_BYTES = 139776;
__global__ void __launch_bounds__(512, 2) fwd_kernel(Params p) {
    extern __shared__ __attribute__((aligned(16))) unsigned char lds_raw[];
    LAS unsigned char* lds = (LAS unsigned char*)lds_raw;
    const int G = gridDim.x;
    const int ph_lo = p.ph_lo, ph_hi = p.ph_hi;
    volatile LAS unsigned* bst = (volatile LAS unsigned*)(lds + 131072);
    if (threadIdx.x == 0) { bst[0] = 0u; bst[1] = 0u; (void)xb_add((unsigned*)(p.ws + OFF_BAR) + XB_XCNT(xb_xcc_id()), 1u); }
    __syncthreads();
#pragma unroll 1
    for (int ph = ph_lo; ph < ph_hi; ++ph) {
        const CAS Params* pp = (const CAS Params*)__builtin_amdgcn_kernarg_segment_ptr(); asm volatile("" : "+s"(pp));
        unsigned char* ws = as_global(pp->ws);
#define IN(k) as_global(pp->in[k])
        float* const outp = as_global(pp->out);
        float* mod = (float*)(ws + OFF_MOD);
        bf16_t* Wt = (bf16_t*)(ws + OFF_W);
        bf16_t* Hb = (bf16_t*)(ws + OFF_H);
        unsigned char* big = ws + OFF_BIG;
        int tid = threadIdx.x; asm volatile("" : "+v"(tid));
        int bid = blockIdx.x; asm volatile("" : "+s"(bid));
        const PhTab* tp = &PHT; asm volatile("" : "+s"(tp));
        const int type = tp->t[ph][0], L = tp->t[ph][1], arg = tp->t[ph][2], xin_flag = tp->t[ph][3];
        const float* modL = mod + (size_t)L * 4 * 6144;
        const float* xcur = (xin_flag & 1) ? IN(0) : (const float*)outp;
#ifndef PHASE_MASK
#define PHASE_MASK 0xfff
#endif
#define PM(k) ((PHASE_MASK >> (k)) & 1)
        switch (type) {
        case 0: if (PM(0)) p0_phase(tid, bid, pp, ws, lds); break;
        case 1: if (PM(1) && arg < 2) {
            const float* gain = (arg == 0 ? IN(4) : IN(5)) + L * 1024;
            norm_phase(tid, bid, xcur, gain, modL + (arg == 0 ? 0 : 3072), modL + (arg == 0 ? 1024 : 4096), Hb);
        } break;
        case 2: if (PM(2)) {
            pg8::Gemm g{Hb, Wt + (L == 0 ? WA_IN : WD_IN), NTOK, 2048, 1024};
            pg8::EpiBf<0, false, true, 1, 512> E; E.part = nullptr; E.abuf = nullptr; E.qgain = nullptr; E.kgain = nullptr; E.lt = nullptr; E.O = (bf16_t*)(big + B_QK); E.ldc = 0;
            if (L == 0) { E.qgain = IN(9); E.kgain = IN(10); E.lt = (LAS float*)(lds + 131072 + 64); }
            pg8::StaticOrder S; S.init(NTOK, 2048, G, bid); pg8::gemm_phase<pg8::EpiBf<0, false, true, 1, 512>, pg8::StaticOrder, true, true>(tid, lds, g, S, E);
        } break;
        case 12: if (PM(2)) {
            const bf16_t* W = Wt + (arg == 0 ? WA_IN + (size_t)2048 * 1024 : (arg == 1 ? WD_IN + (size_t)2048 * 1024 : WC_IN + (size_t)2304 * 1024));
            pg8::Gemm g{W, Hb, 1024, NTOK, 1024};
            pg8::EpiBf<0, false, true, 512, 1> E; E.part = nullptr; E.abuf = nullptr; E.qgain = nullptr; E.kgain = nullptr; E.lt = nullptr; E.O = (bf16_t*)(big + B_VT); E.ldc = 0;
            pg8::StaticOrder S; S.init(1024, NTOK, G, bid); pg8::gemm_phase<pg8::EpiBf<0, false, true, 512, 1>, pg8::StaticOrder, true, true>(tid, lds, g, S, E);
        } break;
        case 13: if (PM(2)) {
            pg8::Gemm g{Hb, Wt + WC_IN, NTOK, 2304, 1024};
            pg8::EpiBf<0, false, true, 1, 512, 8> E; E.part = nullptr; E.abuf = (float*)(ws + OFF_ABUF); E.qgain = nullptr; E.kgain = nullptr; E.lt = nullptr; E.O = (bf16_t*)(big + B_QK); E.ldc = 0;
            pg8::StaticOrder S; S.init(NTOK, 2304, G, bid); pg8::gemm_phase<pg8::EpiBf<0, false, true, 1, 512, 8>, pg8::StaticOrder, true, true>(tid, lds, g, S, E);
        } break;
        case 10: if (PM(10)) {
            pg8::Gemm g{Hb, Wt + W_F1 + (size_t)L * 4194304, NTOK, 4096, 1024};
            pg8::EpiBf<2, false> E; E.part = nullptr; E.abuf = nullptr; E.qgain = nullptr; E.kgain = nullptr; E.lt = nullptr; E.O = (bf16_t*)(big + B_HID); E.ldc = 4096;
            pg8::StaticOrder S; S.init(NTOK, 4096, G, bid); pg8::gemm_phase<pg8::EpiBf<2, false>, pg8::StaticOrder, true, true>(tid, lds, g, S, E);
        } break;
        case 11: if (PM(11)) {
            pg8::Gemm g{Hb + (size_t)arg * 16384 * 1024, Wt + WB_IN, 16384, 3072, 1024};
            pg8::EpiBf<1, false> E; E.part = nullptr; E.abuf = nullptr; E.qgain = nullptr; E.kgain = nullptr; E.lt = nullptr; E.O = (bf16_t*)(big + B_U) + (size_t)arg * 16384 * 3072; E.ldc = 3072;
            pg8::StaticOrder S; S.init(16384, 3072, G, bid); pg8::gemm_phase<pg8::EpiBf<1, false>, pg8::StaticOrder, true, true>(tid, lds, g, S, E);
        } break;
        case 14: if (PM(11)) {
            pg8::Gemm g{Wt + WB_IN + (size_t)3072 * 1024, Hb + (size_t)arg * 16384 * 1024, 3072, 16384, 1024};
            pg8::EpiBf<1, true, true, 256, 1> E; E.part = (float*)(ws + OFF_PART); E.abuf = nullptr; E.qgain = nullptr; E.kgain = nullptr; E.lt = nullptr; E.O = (bf16_t*)(big + B_VTB); E.ldc = 0;
            pg8::StaticOrder S; S.init(3072, 16384, G, bid); pg8::gemm_phase<pg8::EpiBf<1, true, true, 256, 1>, pg8::StaticOrder, true, true>(tid, lds, g, S, E);
        } break;
        case 3: if (PM(3)) {
            pg8::Gemm g{Hb, Wt + (L == 0 ? WA_OUT : (L == 2 ? WC_OUT : WD_OUT)), NTOK, 1024, 1024};
            pg8::EpiResid E; E.xin = xcur; E.xout = outp; E.gate = modL + 2048;
            pg8::StaticOrder S; S.init(NTOK, 1024, G, bid); pg8::gemm_phase<pg8::EpiResid, pg8::StaticOrder, true, true>(tid, lds, g, S, E);
        } break;
        case 15: if (PM(3)) {
            pg8::Gemm g{(const bf16_t*)(big + B_U), Wt + WB_OUT, NTOK, 1024, 3072};
            pg8::EpiResid E; E.xin = xcur; E.xout = outp; E.gate = modL + 2048;
            pg8::StaticOrder S; S.init(NTOK, 1024, G, bid); pg8::gemm_phase<pg8::EpiResid, pg8::StaticOrder, true, true>(tid, lds, g, S, E);
        } break;
        case 16: if (PM(3)) {
            pg8::Gemm g{(const bf16_t*)(big + B_HID), Wt + W_F2 + (size_t)L * 4194304, NTOK, 1024, 4096};
            pg8::EpiResid E; E.xin = xcur; E.xout = outp; E.gate = modL + 5120;
            pg8::StaticOrder S; S.init(NTOK, 1024, G, bid); pg8::gemm_phase<pg8::EpiResid, pg8::StaticOrder, true, true>(tid, lds, g, S, E);
        } break;
        case 17: if (PM(4)) qknorm_phase(tid, bid, (bf16_t*)(big + B_QK), IN(9), IN(10)); break;
        case 4: if (PM(4)) attn_a_phase(tid, bid, lds, (const bf16_t*)(big + B_QK), (const bf16_t*)(big + B_VT), Hb, IN(11)); break;
        case 5: if (PM(5)) b_p2_phase(tid, bid, lds, arg, (bf16_t*)(big + B_U), (const bf16_t*)(big + B_VTB), (const float*)(ws + OFF_PART), IN(15), IN(16), IN(14)); break;
        case 6: if (PM(6)) c_p1_phase(tid, bid, lds, (bf16_t*)(big + B_QK), (const bf16_t*)(big + B_VT), (const float*)(ws + OFF_ABUF), (float*)(ws + OFF_DBUF), (bf16_t*)(big + B_ATT), (bf16_t*)(big + B_DS), IN(19), IN(20)); break;
        case 7: if (PM(7)) c_p2_phase(tid, bid, (bf16_t*)(big + B_DS), (const float*)(ws + OFF_DBUF)); break;
        case 8: if (PM(8)) c_p3_phase(tid, bid, (const bf16_t*)(big + B_QK), (const bf16_t*)(big + B_VT), (const bf16_t*)(big + B_ATT), (const bf16_t*)(big + B_DS), Hb, IN(21)); break;
        default: if (PM(9)) attn_d_phase(tid, bid, (const bf16_t*)(big + B_QK), (const bf16_t*)(big + B_VT), Hb); break;
        }
        if (ph + 1 < ph_hi && !(xin_flag & 2)) { if (ph_hi > 4096) cg::this_grid().sync(); else xcd_barrier((unsigned*)(ws + OFF_BAR), bst); }
    }
}


#ifdef DEBUG_DUMP
__global__ void dump_kernel(float* out, const unsigned char* ws, int which) {
    const unsigned char* big = ws + OFF_BIG;
    const bf16_t* QKR = (const bf16_t*)(big + B_QK); const bf16_t* VT = (const bf16_t*)(big + B_VT); const bf16_t* DS = (const bf16_t*)(big + B_DS); const bf16_t* ATT = (const bf16_t*)(big + B_ATT);
    const float* abuf = (const float*)(ws + OFF_ABUF); const float* dbuf = (const float*)(ws + OFF_DBUF); const bf16_t* Hb = (const bf16_t*)(ws + OFF_H);
    for (size_t i = (size_t)blockIdx.x * blockDim.x + threadIdx.x; i < (size_t)NTOK * DM; i += (size_t)gridDim.x * blockDim.x) {
        float v = 0.f;
        if (which == 0) v = bf2f(QKR[2 * i]) + bf2f(QKR[2 * i + 1]) + bf2f(VT[i]) + abuf[i & 524287];
        else if (which == 1) v = bf2f(DS[2 * i]) + bf2f(DS[2 * i + 1]) + bf2f(ATT[i & 8388607]) + dbuf[i & 262143] + bf2f(QKR[2 * i]) + bf2f(QKR[2 * i + 1]);
        else if (which == 2) v = bf2f(DS[2 * i]) + bf2f(DS[2 * i + 1]);
        else v = bf2f(Hb[i]);
        out[i] = v;
    }
}
#endif
extern "C" void kernel_launch(void* const* d_in, const int* in_sizes, int n_in, void* d_out, int out_size, void* d_ws, size_t ws_size, hipStream_t stream) {
    static int grid = 0;
    if (grid == 0) {
        if (n_in != 25 || out_size != NTOK * DM || ws_size < WS_NEED) { fprintf(stderr, "kernel_launch: unexpected shapes (n_in %d, out %d, ws %zu); nothing launched\n", n_in, out_size, ws_size); grid = -1; return; }
        int dev = 0, cus = 0, per_cu = 0;
        (void)hipGetDevice(&dev);
        (void)hipDeviceGetAttribute(&cus, hipDeviceAttributeMultiprocessorCount, dev);
        if (hipFuncSetAttribute((const void*)fwd_kernel, hipFuncAttributeMaxDynamicSharedMemorySize, LDS_BYTES) != hipSuccess) { fprintf(stderr, "kernel_launch: hipFuncSetAttribute failed\n"); grid = -1; return; }
        if (hipOccupancyMaxActiveBlocksPerMultiprocessor(&per_cu, (const void*)fwd_kernel, 512, LDS_BYTES) != hipSuccess || per_cu < 1) { fprintf(stderr, "kernel_launch: occupancy query says %d\n", per_cu); per_cu = 1; }
        (void)hipGetLastError();
        grid = cus * per_cu;
        if (grid < 1) grid = 256;
    }
    if (grid < 0) return;
    Params p{};
    for (int i = 0; i < 25; ++i) p.in[i] = (const float*)d_in[i];
    p.out = (float*)d_out; p.ws = (unsigned char*)d_ws;
#ifdef DEBUG_MEMSET
    (void)hipMemsetAsync(d_ws, 0, WS_NEED, stream); (void)hipMemsetAsync(d_out, 0, (size_t)out_size * 4, stream);
#endif
    (void)hipMemsetAsync((unsigned char*)d_ws + OFF_BAR, 0, XCD_BAR_WORDS * 4, stream);
#if MULTI_LAUNCH
#ifndef NPH_RUN
#define NPH_RUN NPHASE
#endif
    for (int ph = 0; ph < NPH_RUN; ++ph) { p.ph_lo = ph; p.ph_hi = ph + 1; hipLaunchKernelGGL(fwd_kernel, dim3(grid), dim3(512), LDS_BYTES, stream, p); }
#ifdef DEBUG_DUMP
    hipLaunchKernelGGL(dump_kernel, dim3(2048), dim3(256), 0, stream, (float*)d_out, (const unsigned char*)d_ws, DEBUG_DUMP);
#endif
#else
    p.ph_lo = 0; p.ph_hi = NPHASE;
    void* args[] = {&p};
    hipError_t e = hipLaunchCooperativeKernel((const void*)fwd_kernel, dim3(grid), dim3(512), args, LDS_BYTES, stream);
    if (e != hipSuccess) fprintf(stderr, "kernel_launch: cooperative launch failed: %s (grid %d)\n", hipGetErrorString(e), grid);
#endif
}
```

```cpp
#include <hip/hip_runtime.h>
#include <hip/hip_cooperative_groups.h>
#include <cstdio>
#include <cstdint>
namespace cg = cooperative_groups;

#ifndef MULTI_LAUNCH
#define MULTI_LAUNCH 0
#endif

#define LAS __attribute__((address_space(3)))
typedef unsigned short bf16_t;
typedef short bf16x8 __attribute__((ext_vector_type(8)));
typedef float f32x4 __attribute__((ext_vector_type(4)));
typedef float f32x2 __attribute__((ext_vector_type(2)));
typedef unsigned u32x4 __attribute__((ext_vector_type(4)));
typedef unsigned u32x2 __attribute__((ext_vector_type(2)));

namespace pg8 {
constexpr int BM = 256, BK = 64, HALF = 128, HTB = HALF * BK * 2, STAGE_BYTES = 8 * HTB, NXCD = 8, WGM = 8;
__host__ __device__ __forceinline__ int lds_byte(int r, int c) { const int st = (r >> 4) * 2 + (c >> 5), rr = r & 15, cc = c & 31, ob = rr * 64 + cc * 2; return st * 1024 + (ob ^ (((ob >> 9) & 1) << 5)); }
__host__ __device__ __forceinline__ void stage_rc(int b, int& R, int& C) { const int st = b / 1024, sb = b % 1024, swz = sb ^ (((sb >> 9) & 1) << 5); R = (st >> 1) * 16 + swz / 64; C = (st & 1) * 32 + (swz % 64) / 2; }
__host__ __device__ __forceinline__ int perm32(int rho) { const int n = rho >> 4, i = rho & 15; return 8 * (i >> 2) + 4 * n + (i & 3); }
struct Unit { int pm, pn; };
struct Gemm { const bf16_t* A; const bf16_t* Bt; int M, N, K; };
struct StaticOrder {
    int nM, nN, nwg, G, c;
    __host__ __device__ void init(int M, int N, int G_, int c_) { nM = M / BM; nN = N / BM; nwg = nM * nN; G = G_; c = c_; }
    __host__ __device__ bool next(int i, Unit& u) const {
        const int L = i * G + c; if (L >= nwg) return false;
        int wgid = L; { const int q = nwg / NXCD, r = nwg % NXCD, xcd = wgid % NXCD, off = wgid / NXCD; wgid = (xcd < r ? xcd * (q + 1) : r * (q + 1) + (xcd - r) * q) + off; }
        const int nig = WGM * nN, gid = wgid / nig, fm = gid * WGM, gsz = (nM - fm) < WGM ? (nM - fm) : WGM, gsh = (gsz == 8) ? 3 : 2, w = wgid - gid * nig;
        u.pm = fm + (w & (gsz - 1)); u.pn = w >> gsh;
#if defined(__HIP_DEVICE_COMPILE__)
        u.pm = __builtin_amdgcn_readfirstlane(u.pm); u.pn = __builtin_amdgcn_readfirstlane(u.pn);
#endif
        return true;
    }
    __device__ __forceinline__ void a_ready(const Unit&) const {}
    __device__ __forceinline__ void done(const Unit&) const {}
};
typedef __bf16 bf16v2 __attribute__((ext_vector_type(2)));
__device__ __forceinline__ unsigned cvt_pk_bf16(float lo, float hi) { const f32x2 v = {lo, hi}; const bf16v2 b = __builtin_convertvector(v, bf16v2); return __builtin_bit_cast(unsigned, b); }
__device__ __forceinline__ f32x2 gelu_pk(f32x2 v) {
    const f32x2 av = __builtin_elementwise_abs(v), d = av * 0.2316418882f + 1.0f;
    f32x2 t; t.x = __builtin_amdgcn_rcpf(d.x); t.y = __builtin_amdgcn_rcpf(d.y);
    f32x2 q = t * 0.5307027145f + (-0.7265760135f); q = q * t + 0.7107068705f; q = q * t + (-0.142248368f); q = q * t + 0.127414796f; q = q * t;
    const f32x2 s = (v * v) * (-0.72134752044f);
    f32x2 e; e.x = __builtin_amdgcn_exp2f(s.x); e.y = __builtin_amdgcn_exp2f(s.y);
    const f32x2 m = v * (q * e), r = v - m;
    f32x2 o; o.x = v.x < 0.f ? m.x : r.x; o.y = v.y < 0.f ? m.y : r.y; return o;
}

template <int ACT, bool COLSUM, bool BLK = false, int sr = 0, int sc = 0, int a_pn = (1 << 30)> struct EpiBf {
    static constexpr bool PERM = true, AFTER_DRAIN = false;
    bf16_t* O; int ldc; float* part; float* abuf;
    const float* qgain; const float* kgain; LAS float* lt;
    __device__ __forceinline__ void operator()(const f32x4 (&acc)[2][2][4][2], const Unit& u, int wr, int wc, int fr, int fq) const {
        const int row0 = u.pm * BM + wr * 64 + fr;
        const bool hn = (ACT == 0) && (qgain != nullptr);
        if (hn) {
#pragma unroll
            for (int ai = 0; ai < 2; ++ai)
#pragma unroll
                for (int m = 0; m < 4; ++m)
#pragma unroll
                    for (int bj = 0; bj < 2; ++bj) { const f32x4 a = acc[ai][bj][m][0], b = acc[ai][bj][m][1];
                        float q = (a[0] * a[0] + a[1] * a[1]) + (a[2] * a[2] + a[3] * a[3]) + (b[0] * b[0] + b[1] * b[1]) + (b[2] * b[2] + b[3] * b[3]);
                        const int ln = fq * 16 + fr;
                        q += __builtin_bit_cast(float, __builtin_amdgcn_ds_bpermute((ln ^ 16) << 2, __builtin_bit_cast(int, q)));
                        q += __builtin_bit_cast(float, __builtin_amdgcn_ds_bpermute((ln ^ 32) << 2, __builtin_bit_cast(int, q)));
                        if (fq == 0) lt[((ai * HALF + wr * 64 + m * 16 + fr) * 2 + bj) * 4 + wc] = q; }
            asm volatile("s_waitcnt lgkmcnt(0)" ::: "memory"); __builtin_amdgcn_s_barrier(); asm volatile("" ::: "memory");
        }
        if (ACT == 0 && u.pn >= a_pn) {
            if (wc == 0 && fq < 2) {
#pragma unroll
                for (int ai = 0; ai < 2; ++ai)
#pragma unroll
                    for (int m = 0; m < 4; ++m) { float* rp = abuf + (size_t)(row0 + ai * HALF + m * 16) * 16 + 8 * fq;
#pragma unroll
                        for (int n = 0; n < 2; ++n) *(f32x4*)(rp + 4 * n) = acc[ai][0][m][n]; }
            }
            return;
        }
        const int col0 = u.pn * BM + wc * 32 + 8 * fq;
        float cs[2][2][4];
#pragma unroll
        for (int bj = 0; bj < 2; ++bj)
#pragma unroll
            for (int n = 0; n < 2; ++n)
#pragma unroll
                for (int e = 0; e < 4; ++e) cs[bj][n][e] = 0.f;
#pragma unroll
        for (int ai = 0; ai < 2; ++ai)
#pragma unroll
            for (int m = 0; m < 4; ++m) { const int row = row0 + ai * HALF + m * 16; const unsigned roff = BLK ? (unsigned)((row >> 6) * sr * 4096 + (row & 63) * 64) : (unsigned)row * (unsigned)ldc + (unsigned)col0;
#pragma unroll
                for (int bj = 0; bj < 2; ++bj) { f32x4 v0 = acc[ai][bj][m][0], v1 = acc[ai][bj][m][1];
                    if (hn) { const int rl = ai * HALF + wr * 64 + m * 16 + fr; const LAS float* pp = lt + (rl * 2 + bj) * 4 + (wc & 2);
                        const float rr = rsqrtf((pp[0] + pp[1]) * (1.f / 64.f) + 1e-6f); const bool isq = u.pn < 4; const int d0 = ((wc & 1) * 32 + 8 * fq);
                        const float* gp = (isq ? qgain : kgain) + d0; const f32x4 ga = *(const f32x4*)gp, gb = *(const f32x4*)(gp + 4);
                        const float sc2 = isq ? rr * (0.125f * 1.4426950408889634f) : rr;
                        v0 = v0 * ga * sc2; v1 = v1 * gb * sc2; }
                    if (ACT == 1) { f32x2 a = gelu_pk((f32x2){v0[0], v0[1]}), b = gelu_pk((f32x2){v0[2], v0[3]}), c = gelu_pk((f32x2){v1[0], v1[1]}), d = gelu_pk((f32x2){v1[2], v1[3]});
                        v0 = (f32x4){a.x, a.y, b.x, b.y}; v1 = (f32x4){c.x, c.y, d.x, d.y}; }
                    else if (ACT == 2) {
#pragma unroll
                        for (int e = 0; e < 4; ++e) { float a = fmaxf(v0[e], 0.f), b = fmaxf(v1[e], 0.f); v0[e] = a * a; v1[e] = b * b; } }
                    if (COLSUM && part) {
#pragma unroll
                        for (int e = 0; e < 4; ++e) { cs[bj][0][e] += v0[e] * v0[e]; cs[bj][1][e] += v1[e] * v1[e]; } }
                    u32x4 w; w.x = cvt_pk_bf16(v0[0], v0[1]); w.y = cvt_pk_bf16(v0[2], v0[3]); w.z = cvt_pk_bf16(v1[0], v1[1]); w.w = cvt_pk_bf16(v1[2], v1[3]);
                    if (BLK) { const int col = col0 + bj * HALF; *(u32x4*)(O + (roff + (unsigned)((col >> 6) * sc * 4096 + (col & 63)))) = w; } else *(u32x4*)(O + (roff + bj * HALF)) = w; }
                asm volatile("" ::: "memory"); }
        if (hn) { asm volatile("s_waitcnt lgkmcnt(0)" ::: "memory"); __builtin_amdgcn_s_barrier(); asm volatile("" ::: "memory"); }
        if (COLSUM && part) {
#pragma unroll
            for (int bj = 0; bj < 2; ++bj)
#pragma unroll
                for (int n = 0; n < 2; ++n)
#pragma unroll
                    for (int e = 0; e < 4; ++e) { float s = cs[bj][n][e];
                        { const int ln = fq * 16 + fr; s += __builtin_bit_cast(float, __builtin_amdgcn_ds_bpermute((ln ^ 1) << 2, __builtin_bit_cast(int, s))); s += __builtin_bit_cast(float, __builtin_amdgcn_ds_bpermute((ln ^ 2) << 2, __builtin_bit_cast(int, s))); s += __builtin_bit_cast(float, __builtin_amdgcn_ds_bpermute((ln ^ 4) << 2, __builtin_bit_cast(int, s))); s += __builtin_bit_cast(float, __builtin_amdgcn_ds_bpermute((ln ^ 8) << 2, __builtin_bit_cast(int, s))); }
                        if (fr == 0) part[(size_t)(col0 + bj * HALF + 4 * n + e) * 24 + u.pm * 2 + wr] = s; }
        }
    }
};
struct EpiResid {
    static constexpr bool PERM = false, AFTER_DRAIN = false;
    const float* xin; float* xout; const float* gate;
    __device__ __forceinline__ void operator()(const f32x4 (&acc)[2][2][4][2], const Unit& u, int wr, int wc, int fr, int fq) const {
        const int row0 = u.pm * BM + wr * 64 + fr, col0 = u.pn * BM + wc * 32 + 4 * fq;
        const float* gp = gate + (size_t)(u.pm >> 5) * 6144 + col0;
#pragma unroll
        for (int bj = 0; bj < 2; ++bj)
#pragma unroll
            for (int n = 0; n < 2; ++n) { const f32x4 gv = *(const f32x4*)(gp + bj * HALF + n * 16);
#pragma unroll
                for (int ai = 0; ai < 2; ++ai)
#pragma unroll
                    for (int m = 0; m < 4; ++m) { const unsigned off = (unsigned)((row0 + ai * HALF + m * 16) * 1024 + col0 + bj * HALF + n * 16);
                        const f32x4 xi = *(const f32x4*)(xin + off); *(f32x4*)(xout + off) = xi + gv * acc[ai][bj][m][n];
                        if (m == 3 && ai == 1 && n == 1) asm volatile("" ::: "memory"); } }
    }
};

__device__ __forceinline__ const char* uni(const char* p) { const unsigned long long v = (unsigned long long)p;
    const unsigned lo = __builtin_amdgcn_readfirstlane((unsigned)v), hi = __builtin_amdgcn_readfirstlane((unsigned)(v >> 32)); return (const char*)(((unsigned long long)hi << 32) | lo); }
template <class Epi, class Sched, bool ALIGN_EPI = false, bool SP2 = false>
__device__ __forceinline__ void gemm_phase(const int tid, LAS unsigned char* lds, const Gemm g, const Sched& S, const Epi& E) {
    const int wid = __builtin_amdgcn_readfirstlane(tid >> 6), lane = tid & 63, wr = wid >> 2, wc = wid & 3, fr = lane & 15, fq = lane >> 4;
    const int K = g.K, nt = K / BK;
    unsigned voffA[2], voffB[2];
#pragma unroll
    for (int i = 0; i < 2; ++i) { int R, C; stage_rc(tid * 16 + i * 8192, R, C); const int Rb = Epi::PERM ? ((R & ~31) + perm32(R & 31)) : R;
        voffA[i] = (unsigned)(R * K + C) * 2u; voffB[i] = (unsigned)(Rb * K + C) * 2u; }
    const size_t kstep = (size_t)(BK * 2);
    const size_t hstep = (size_t)HALF * K * 2;
    const size_t tstep = 2 * hstep;
    const unsigned ldsw = (unsigned)wid * 1024u;
    const int aoff = lds_byte(wr * 64 + fr, fq * 8), boff = lds_byte(wc * 32 + fr, fq * 8);
#define PG8_SA(b, h) (((b) * 2 + (h)) * HTB)
#define PG8_SB(b, h) ((4 + (b) * 2 + (h)) * HTB)
#define PG8_STAGE(bufoff, gbase, voff) do { _Pragma("unroll") for (int _i = 0; _i < 2; ++_i) \
        __builtin_amdgcn_global_load_lds((const unsigned*)((const char*)(gbase) + (voff)[_i]), (LAS unsigned*)(lds + (bufoff) + ldsw + _i * 8192), 16, 0, 0); } while (0)
#define PG8_LDA(dst, b, h) do { _Pragma("unroll") for (int m = 0; m < 4; ++m) _Pragma("unroll") for (int k = 0; k < 2; ++k) dst[m][k] = *(const LAS bf16x8*)(lds + PG8_SA(b, h) + aoff + m * 2048 + k * 1024); } while (0)
#define PG8_LDB(dst, b, h) do { _Pragma("unroll") for (int n = 0; n < 2; ++n) _Pragma("unroll") for (int k = 0; k < 2; ++k) dst[n][k] = *(const LAS bf16x8*)(lds + PG8_SB(b, h) + boff + n * 2048 + k * 1024); } while (0)
#define PG8_MMA(ai, bj, At, Bt) do { __builtin_amdgcn_s_setprio(1); _Pragma("unroll") for (int m = 0; m < 4; ++m) _Pragma("unroll") for (int n = 0; n < 2; ++n) _Pragma("unroll") for (int k = 0; k < 2; ++k) \
        acc[ai][bj][m][n] = __builtin_amdgcn_mfma_f32_16x16x32_bf16(Bt[n][k], At[m][k], acc[ai][bj][m][n], 0, 0, 0); __builtin_amdgcn_s_setprio(0); } while (0)
#define PG8_WAIT_V(n) asm volatile("s_waitcnt vmcnt(" #n ")" ::: "memory")
#define PG8_WAIT_L(n) asm volatile("s_waitcnt lgkmcnt(" #n ")" ::: "memory")
#define PG8_BAR __builtin_amdgcn_s_barrier()
#define PG8_SCHED __builtin_amdgcn_sched_barrier(0)
    Unit cur, nxt; int ui = 0;
    if (!S.next(0, cur)) return;
    f32x4 acc[2][2][4][2];
#pragma unroll
    for (int a = 0; a < 2; ++a)
#pragma unroll
        for (int b = 0; b < 2; ++b)
#pragma unroll
            for (int m = 0; m < 4; ++m)
#pragma unroll
                for (int n = 0; n < 2; ++n) acc[a][b][m][n] = (f32x4){0.f, 0.f, 0.f, 0.f};
    bf16x8 At[4][2], B0[2][2], B1[2][2];
    const char* cA = uni((const char*)g.A + (size_t)cur.pm * tstep); const char* cB = uni((const char*)g.Bt + (size_t)cur.pn * tstep);
    S.a_ready(cur);
    if constexpr (SP2) {
        PG8_STAGE(PG8_SB(0, 0), cB, voffB); PG8_STAGE(PG8_SB(0, 1), cB + hstep, voffB); PG8_STAGE(PG8_SA(0, 0), cA, voffA); PG8_STAGE(PG8_SA(0, 1), cA + hstep, voffA);
        if (wr == 1) PG8_BAR;
        PG8_WAIT_V(2); PG8_BAR;
        PG8_STAGE(PG8_SB(1, 0), cB + kstep, voffB); PG8_STAGE(PG8_SA(1, 0), cA + kstep, voffA); PG8_STAGE(PG8_SB(1, 1), cB + hstep + kstep, voffB);
        PG8_WAIT_V(6); PG8_BAR;
    } else {
        PG8_STAGE(PG8_SB(0, 0), cB, voffB); PG8_STAGE(PG8_SA(0, 0), cA, voffA); PG8_STAGE(PG8_SB(0, 1), cB + hstep, voffB); PG8_STAGE(PG8_SA(0, 1), cA + hstep, voffA);
        if (wr == 1) PG8_BAR;
        PG8_WAIT_V(4); PG8_BAR;
        PG8_STAGE(PG8_SB(1, 0), cB + kstep, voffB); PG8_STAGE(PG8_SA(1, 0), cA + kstep, voffA); PG8_STAGE(PG8_SB(1, 1), cB + hstep + kstep, voffB);
        PG8_WAIT_V(6); PG8_BAR;
    }
    for (;;) {
        const bool has_next = S.next(ui + 1, nxt);
        const char* nA = uni(has_next ? (const char*)g.A + (size_t)nxt.pm * tstep : cA); const char* nB = uni(has_next ? (const char*)g.Bt + (size_t)nxt.pn * tstep : cB);
        for (int t = 0; t < nt; t += 2) {
            const bool last = (t == nt - 2);
            const char* a1 = uni(cA + (size_t)(t + 1) * kstep);
            const char* a2 = uni(last ? nA : cA + (size_t)(t + 2) * kstep); const char* b2 = uni(last ? nB : cB + (size_t)(t + 2) * kstep);
            const char* a3 = a2 + kstep; const char* b3 = b2 + kstep;
            if (last && has_next) S.a_ready(nxt);
            if constexpr (SP2) {
            PG8_LDB(B0, 0, 0); PG8_LDB(B1, 0, 1); PG8_SCHED; PG8_LDA(At, 0, 0); PG8_STAGE(PG8_SA(1, 1), a1 + hstep, voffA);
            PG8_WAIT_V(8); PG8_WAIT_L(0); PG8_BAR; PG8_MMA(0, 0, At, B0); PG8_MMA(0, 1, At, B1); PG8_BAR; PG8_SCHED;
            PG8_LDA(At, 0, 1); PG8_STAGE(PG8_SB(0, 0), b2, voffB); PG8_STAGE(PG8_SB(0, 1), b2 + hstep, voffB); PG8_STAGE(PG8_SA(0, 0), a2, voffA);
            PG8_WAIT_V(8); PG8_WAIT_L(0); PG8_BAR; PG8_MMA(1, 0, At, B0); PG8_MMA(1, 1, At, B1); PG8_BAR; PG8_SCHED;
            PG8_LDB(B0, 1, 0); PG8_LDB(B1, 1, 1); PG8_SCHED; PG8_LDA(At, 1, 0); PG8_STAGE(PG8_SA(0, 1), a2 + hstep, voffA);
            PG8_WAIT_V(8); PG8_WAIT_L(0); PG8_BAR; PG8_MMA(0, 0, At, B0); PG8_MMA(0, 1, At, B1); PG8_BAR; PG8_SCHED;
            PG8_LDA(At, 1, 1); PG8_STAGE(PG8_SB(1, 0), b3, voffB); PG8_STAGE(PG8_SB(1, 1), b3 + hstep, voffB); PG8_STAGE(PG8_SA(1, 0), a3, voffA);
            PG8_WAIT_V(8); PG8_WAIT_L(0); PG8_BAR; PG8_MMA(1, 0, At, B0); PG8_MMA(1, 1, At, B1); PG8_BAR; PG8_SCHED;
            } else {
            PG8_LDB(B0, 0, 0); PG8_SCHED; PG8_LDA(At, 0, 0); PG8_STAGE(PG8_SA(1, 1), a1 + hstep, voffA);
            PG8_WAIT_L(8); PG8_BAR; PG8_WAIT_L(0); PG8_MMA(0, 0, At, B0); PG8_BAR; PG8_SCHED;
            PG8_LDB(B1, 0, 1); PG8_STAGE(PG8_SB(0, 0), b2, voffB);
            PG8_BAR; PG8_WAIT_L(0); PG8_MMA(0, 1, At, B1); PG8_BAR;
            PG8_LDA(At, 0, 1); PG8_STAGE(PG8_SA(0, 0), a2, voffA);
            PG8_BAR; PG8_WAIT_L(0); PG8_MMA(1, 0, At, B0); PG8_BAR; PG8_SCHED;
            PG8_STAGE(PG8_SB(0, 1), b2 + hstep, voffB);
            PG8_WAIT_V(6); PG8_BAR; PG8_MMA(1, 1, At, B1); PG8_BAR;
            PG8_LDB(B0, 1, 0); PG8_SCHED; PG8_LDA(At, 1, 0); PG8_STAGE(PG8_SA(0, 1), a2 + hstep, voffA);
            PG8_WAIT_L(8); PG8_BAR; PG8_WAIT_L(0); PG8_MMA(0, 0, At, B0); PG8_BAR; PG8_SCHED;
            PG8_LDB(B1, 1, 1); PG8_STAGE(PG8_SB(1, 0), b3, voffB);
            PG8_BAR; PG8_WAIT_L(0); PG8_MMA(0, 1, At, B1); PG8_BAR;
            PG8_LDA(At, 1, 1); PG8_STAGE(PG8_SA(1, 0), a3, voffA);
            PG8_BAR; PG8_WAIT_L(0); PG8_MMA(1, 0, At, B0); PG8_BAR; PG8_SCHED;
            PG8_STAGE(PG8_SB(1, 1), b3 + hstep, voffB);
            PG8_WAIT_V(6); PG8_BAR; PG8_MMA(1, 1, At, B1); PG8_BAR;
            }
        }
        if constexpr (ALIGN_EPI) { if (wr == 0) PG8_BAR; }
        { int fr_e = fr, fq_e = fq; asm volatile("" : "+v"(fr_e), "+v"(fq_e));
          E(acc, cur, wr, wc, fr_e, fq_e); } S.done(cur);
        if (!has_next) break;
#pragma unroll
        for (int a = 0; a < 2; ++a)
#pragma unroll
            for (int b = 0; b < 2; ++b)
#pragma unroll
                for (int m = 0; m < 4; ++m)
#pragma unroll
                    for (int n = 0; n < 2; ++n) acc[a][b][m][n] = (f32x4){0.f, 0.f, 0.f, 0.f};
        cur = nxt; cA = nA; cB = nB; ++ui;
        if constexpr (ALIGN_EPI) { if (wr == 1) PG8_BAR; }
    }
    PG8_WAIT_V(0);
    if constexpr (!ALIGN_EPI) { if (wr == 0) PG8_BAR; }
    PG8_BAR;
#undef PG8_SA
#undef PG8_SB
#undef PG8_STAGE
#undef PG8_LDA
#undef PG8_LDB
#undef PG8_MMA
#undef PG8_WAIT_V
#undef PG8_WAIT_L
#undef PG8_BAR
#undef PG8_SCHED
}
}

constexpr int NTOK = 32768, DM = 1024, SEQ = 8192;
constexpr float EPS = 1e-6f;
constexpr size_t MiB = (size_t)1 << 20;
constexpr size_t OFF_MOD = 0;
constexpr size_t OFF_BAR = 512 * 1024;
constexpr size_t OFF_PART = 1 * MiB;
constexpr size_t OFF_ABUF = 1 * MiB;
constexpr size_t OFF_DBUF = 3 * MiB;
constexpr size_t OFF_W = 4 * MiB;
constexpr size_t OFF_H = 111 * MiB;
constexpr size_t OFF_BIG = 175 * MiB;
constexpr size_t WS_NEED = 511 * MiB;
constexpr size_t WA_IN = 0, WA_OUT = 3145728, WB_IN = 4194304, WB_OUT = 10485760, WC_IN = 13631488, WC_OUT = 17039360, WD_IN = 18087936, WD_OUT = 21233664, W_F1 = 22282240, W_F2 = 39059456, W_END = 55836672;
static_assert(OFF_W + W_END * 2 <= OFF_H, "weights overflow");
constexpr size_t B_QK = 0, B_VT = 128 * MiB;
constexpr size_t B_U = 0, B_VTB = 192 * MiB;
constexpr size_t B_DS = 192 * MiB, B_ATT = 320 * MiB;
constexpr size_t B_HID = 0;

constexpr int NSEG = 19;
struct SegTab { int v[NSEG][9]; int nitems; };
constexpr SegTab make_segs() {
    SegTab r{}; int n = 0, items = 0;
    auto add = [&](int in_idx, long src_off, int K, int ldw, int nsrc0, int ncols, long dst_off, int row_off) {
        r.v[n][0] = in_idx; r.v[n][1] = (int)src_off; r.v[n][2] = (int)dst_off; r.v[n][3] = K; r.v[n][4] = ldw; r.v[n][5] = nsrc0; r.v[n][6] = ncols; r.v[n][7] = row_off; r.v[n][8] = items; ++n;
        items += (K / 64) * ((ncols + 31) / 32); };
    add(8, 0, 1024, 3072, 0, 3072, WA_IN, 0);
    add(12, 0, 1024, 1024, 0, 1024, WA_OUT, 0);
    add(13, 0, 1024, 6144, 0, 6144, WB_IN, 0);
    add(17, 0, 3072, 1024, 0, 1024, WB_OUT, 0);
    add(18, 0, 1024, 3088, 0, 1024, WC_IN, 0);
    add(18, 0, 1024, 3088, 2048, 1024, WC_IN, 1024);
    add(18, 0, 1024, 3088, 3072, 16, WC_IN, 2048);
    add(18, 0, 1024, 3088, 1024, 1024, WC_IN, 2304);
    add(22, 0, 1024, 1024, 0, 1024, WC_OUT, 0);
    add(23, 0, 1024, 3072, 0, 3072, WD_IN, 0);
    add(24, 0, 1024, 1024, 0, 1024, WD_OUT, 0);
    for (int l = 0; l < 4; ++l) add(6, (long)l * 4194304, 1024, 4096, 0, 4096, (long)W_F1 + (long)l * 4194304, 0);
    for (int l = 0; l < 4; ++l) add(7, (long)l * 4194304, 4096, 1024, 0, 1024, (long)W_F2 + (long)l * 4194304, 0);
    r.nitems = items; return r;
}
constexpr int NITEMS = make_segs().nitems;
struct Params {
    const float* in[25];
    float* out; unsigned char* ws;
    int ph_lo, ph_hi;
};

#ifndef DBL_MASK
#define DBL_MASK 0
#endif
constexpr int NBASE = 38;
struct PhTab { unsigned char t[2 * NBASE + 64][4]; int n; };
constexpr PhTab make_tab() {
    const unsigned char base[NBASE][4] = {
        {0, 0, 0, 0},
        {1, 0, 0, 0}, {2, 0, 0, 1}, {12, 0, 0, 0}, {4, 0, 0, 0}, {3, 0, 0, 0}, {1, 0, 1, 0}, {10, 0, 1, 0}, {16, 0, 1, 0},
        {1, 1, 0, 0}, {11, 1, 0, 1}, {14, 1, 0, 0}, {5, 1, 0, 0}, {11, 1, 1, 1}, {14, 1, 1, 0}, {5, 1, 1, 0}, {15, 1, 0, 0}, {1, 1, 1, 0}, {10, 1, 1, 0}, {16, 1, 1, 0},
        {1, 2, 0, 0}, {13, 2, 0, 1}, {12, 2, 2, 0}, {6, 2, 0, 0}, {7, 2, 0, 0}, {8, 2, 0, 0}, {3, 2, 0, 0}, {1, 2, 1, 0}, {10, 2, 1, 0}, {16, 2, 1, 0},
        {1, 3, 0, 0}, {2, 3, 0, 1}, {12, 3, 1, 0}, {9, 3, 0, 0}, {3, 3, 0, 0}, {1, 3, 1, 0}, {10, 3, 1, 0}, {16, 3, 1, 0}};
    PhTab r{}; int n = 0;
    for (int i = 0; i < NBASE; ++i) { const int reps = ((DBL_MASK >> base[i][0]) & 1) ? 2 : 1;
        for (int k = 0; k < reps; ++k) { r.t[n][0] = base[i][0]; r.t[n][1] = base[i][1]; r.t[n][2] = base[i][2]; r.t[n][3] = (unsigned char)(((i <= 5) ? 1 : 0) | ((base[i][3] && k == reps - 1) ? 2 : 0)); ++n; } }
#ifdef EXTRA_SYNCS
    for (int k = 0; k < EXTRA_SYNCS; ++k) { r.t[n][0] = 1; r.t[n][1] = 0; r.t[n][2] = 2; r.t[n][3] = 0; ++n; }
#endif
    r.n = n; return r;
}
constexpr int NPHASE = make_tab().n;
__constant__ PhTab PHT = make_tab();

__device__ __forceinline__ unsigned f2bf(float f) { unsigned u = __builtin_bit_cast(unsigned, f); return (u + 0x7fffu + ((u >> 16) & 1u)) >> 16; }
__device__ __forceinline__ unsigned pk2(float lo, float hi) { return f2bf(lo) | (f2bf(hi) << 16); }
__device__ __forceinline__ float bf2f(unsigned short s) { return __uint_as_float(((unsigned)s) << 16); }
__device__ __forceinline__ bf16x8 ldg8(const bf16_t* p) { return *(const bf16x8*)p; }
__device__ __forceinline__ void unpack8(bf16x8 v, float* f) { const u32x4 u = __builtin_bit_cast(u32x4, v);
#pragma unroll
    for (int i = 0; i < 4; ++i) { f[2 * i] = __uint_as_float(u[i] << 16); f[2 * i + 1] = __uint_as_float(u[i] & 0xffff0000u); } }
__device__ __forceinline__ bf16x8 pack8(const float* f) { u32x4 u;
#pragma unroll
    for (int i = 0; i < 4; ++i) u[i] = pg8::cvt_pk_bf16(f[2 * i], f[2 * i + 1]);
    return __builtin_bit_cast(bf16x8, u); }
__device__ __forceinline__ void unpack4(u32x2 u, float* f) { f[0] = __uint_as_float(u.x << 16); f[1] = __uint_as_float(u.x & 0xffff0000u); f[2] = __uint_as_float(u.y << 16); f[3] = __uint_as_float(u.y & 0xffff0000u); }
__device__ __forceinline__ u32x2 pack4(float a, float b, float c, float d) { u32x2 r; r.x = pg8::cvt_pk_bf16(a, b); r.y = pg8::cvt_pk_bf16(c, d); return r; }
__device__ __forceinline__ f32x4 mfma16(bf16x8 a, bf16x8 b, f32x4 c) { return __builtin_amdgcn_mfma_f32_16x16x32_bf16(a, b, c, 0, 0, 0); }
__device__ __forceinline__ float shx(float v, int lane, int mask) { return __builtin_bit_cast(float, __builtin_amdgcn_ds_bpermute((lane ^ mask) << 2, __builtin_bit_cast(int, v))); }

#define LDS_WAIT() asm volatile("s_waitcnt lgkmcnt(0)" ::: "memory")
#define SB0() __builtin_amdgcn_sched_barrier(0)
#define GAS __attribute__((address_space(1)))
#define CAS __attribute__((address_space(4)))
template <class T> __device__ __forceinline__ T* as_global(T* p) { return (T*)(GAS T*)p; }

struct ItemP { const float* src; bf16_t* dst; int K, ld, n0, nc, ro, idx; };
__device__ __forceinline__ void tr_load(const ItemP& q, int lane, float (&wv)[32]) {
    const int nblk = (q.nc + 31) >> 5, kb = q.idx / nblk, nb = q.idx - kb * nblk, k0 = 64 * kb, n0 = 32 * nb;
    const int nn = n0 + (lane & 31); const bool ok = nn < q.nc;
#pragma unroll
    for (int i = 0; i < 32; ++i) { const int kk = 2 * i + (lane >> 5); wv[i] = ok ? q.src[(size_t)(k0 + kk) * q.ld + q.n0 + nn] : 0.f; }
}
__device__ __forceinline__ void tr_store(const ItemP& q, int lane, const float (&wv)[32], LAS float* scr) {
    const int nblk = (q.nc + 31) >> 5, kb = q.idx / nblk, nb = q.idx - kb * nblk, k0 = 64 * kb, n0 = 32 * nb;
#pragma unroll
    for (int i = 0; i < 32; ++i) { const int kk = 2 * i + (lane >> 5); scr[kk * 33 + (lane & 31)] = wv[i]; }
    LDS_WAIT(); asm volatile("" ::: "memory");
    const int c = lane & 7;
#pragma unroll
    for (int j = 0; j < 4; ++j) { const int n = (lane >> 3) + 8 * j; const LAS float* sp = scr + (8 * c) * 33 + n;
        u32x4 o; o.x = pk2(sp[0 * 33], sp[1 * 33]); o.y = pk2(sp[2 * 33], sp[3 * 33]); o.z = pk2(sp[4 * 33], sp[5 * 33]); o.w = pk2(sp[6 * 33], sp[7 * 33]);
        *(u32x4*)(q.dst + (size_t)(q.ro + n0 + n) * q.K + k0 + 8 * c) = o; }
    LDS_WAIT(); asm volatile("" ::: "memory");
}
__device__ __forceinline__ ItemP tr_decode(int it, const CAS Params* pp, unsigned char* ws) {
    constexpr SegTab ST = make_segs();
    int sidx = ST.v[0][0], ssrc = ST.v[0][1], sdst = ST.v[0][2], sK = ST.v[0][3], sld = ST.v[0][4], sn0 = ST.v[0][5], snc = ST.v[0][6], sro = ST.v[0][7], si0 = 0;
#pragma unroll
    for (int q = 1; q < NSEG; ++q) { const bool t = it >= ST.v[q][8];
        sidx = t ? ST.v[q][0] : sidx; ssrc = t ? ST.v[q][1] : ssrc; sdst = t ? ST.v[q][2] : sdst; sK = t ? ST.v[q][3] : sK; sld = t ? ST.v[q][4] : sld; sn0 = t ? ST.v[q][5] : sn0; snc = t ? ST.v[q][6] : snc; sro = t ? ST.v[q][7] : sro; si0 = t ? ST.v[q][8] : si0; }
    const float* src = pp->in[6];
    src = sidx == 7 ? pp->in[7] : src; src = sidx == 8 ? pp->in[8] : src; src = sidx == 12 ? pp->in[12] : src; src = sidx == 13 ? pp->in[13] : src; src = sidx == 17 ? pp->in[17] : src;
    src = sidx == 18 ? pp->in[18] : src; src = sidx == 22 ? pp->in[22] : src; src = sidx == 23 ? pp->in[23] : src; src = sidx == 24 ? pp->in[24] : src;
    ItemP r; r.src = as_global(src) + (size_t)(unsigned)ssrc; r.dst = (bf16_t*)(ws + OFF_W) + (size_t)(unsigned)sdst; r.K = sK; r.ld = sld; r.n0 = sn0; r.nc = snc; r.ro = sro; r.idx = it - si0;
    return r;
}
__device__ __forceinline__ void p0_phase(const int tid, const int bid, const CAS Params* pp, unsigned char* ws, LAS unsigned char* lds) {
    const int lane = tid & 63, wave = __builtin_amdgcn_readfirstlane(tid >> 6), G = gridDim.x;
    float* mod = (float*)(ws + OFF_MOD);
    const float* cin = as_global(pp->in[1]); const float* ada_w = as_global(pp->in[2]); const float* ada_b = as_global(pp->in[3]);
    for (int item = bid; item < 256; item += G) {
        const int L = item >> 6, cgp = item & 63, c4 = lane % 24, kq = lane / 24, k0 = wave * 128;
        f32x4 a0 = {0.f, 0.f, 0.f, 0.f}, a1 = a0, a2 = a0, a3 = a0;
        if (kq < 2) {
            const float* wp = ada_w + ((size_t)L * 1024 + k0 + kq) * 6144 + cgp * 96 + 4 * c4;
#pragma unroll 8
            for (int k = 0; k < 64; ++k) {
                const f32x4 w4 = *(const f32x4*)(wp + (size_t)(2 * k) * 6144);
                const int kk = k0 + kq + 2 * k;
                const float c0 = cin[kk], c1 = cin[1024 + kk], c2 = cin[2048 + kk], c3 = cin[3072 + kk];
                a0 += w4 * (c0 / (1.f + __expf(-c0))); a1 += w4 * (c1 / (1.f + __expf(-c1))); a2 += w4 * (c2 / (1.f + __expf(-c2))); a3 += w4 * (c3 / (1.f + __expf(-c3)));
            }
        }
        LAS float* red = (LAS float*)lds;
        if (kq < 2) { const int kg = wave * 2 + kq;
            *(LAS f32x4*)(red + (kg * 4 + 0) * 96 + 4 * c4) = a0; *(LAS f32x4*)(red + (kg * 4 + 1) * 96 + 4 * c4) = a1;
            *(LAS f32x4*)(red + (kg * 4 + 2) * 96 + 4 * c4) = a2; *(LAS f32x4*)(red + (kg * 4 + 3) * 96 + 4 * c4) = a3; }
        __syncthreads();
        if (tid < 384) { const int b = tid / 96, cc = tid - b * 96; float s = ada_b[L * 6144 + cgp * 96 + cc];
#pragma unroll
            for (int w = 0; w < 16; ++w) s += red[(w * 4 + b) * 96 + cc];
            mod[(size_t)(L * 4 + b) * 6144 + cgp * 96 + cc] = s; }
        __syncthreads();
    }
    LAS float* scr = (LAS float*)(lds + wave * 16384);
    const int gw = bid * 8 + wave, NGW = G * 8;
    for (int it = gw; it < NITEMS; it += 2 * NGW) {
        const int it2 = it + NGW; const bool has2 = it2 < NITEMS;
        const ItemP qa = tr_decode(it, pp, ws), qb = tr_decode(has2 ? it2 : it, pp, ws);
        float wa[32], wb[32];
        tr_load(qa, lane, wa); tr_load(qb, lane, wb);
        SB0();
        tr_store(qa, lane, wa, scr);
        if (has2) tr_store(qb, lane, wb, scr);
    }
}

__device__ __forceinline__ void norm_phase(const int tid, const int bid, const float* x, const float* gain, const float* sh, const float* sc, bf16_t* H) {
    const int lane = tid & 63, wave = __builtin_amdgcn_readfirstlane(tid >> 6);
    const int gw = bid * 8 + wave, NGW = gridDim.x * 8;
    for (int row0 = gw * 4; row0 < NTOK; row0 += NGW * 4) {
        const int b = row0 >> 13;
        f32x4 v[4][4];
#pragma unroll
        for (int r = 0; r < 4; ++r)
#pragma unroll
            for (int j = 0; j < 4; ++j) v[r][j] = *((const f32x4*)(x + (size_t)(row0 + r) * DM) + lane + 64 * j);
        f32x4 gm[4], hh[4];
#pragma unroll
        for (int j = 0; j < 4; ++j) { const f32x4 gn = *((const f32x4*)gain + lane + 64 * j), s4 = *((const f32x4*)(sc + (size_t)b * 6144) + lane + 64 * j); gm[j] = gn * (s4 + 1.f); hh[j] = *((const f32x4*)(sh + (size_t)b * 6144) + lane + 64 * j); }
        SB0();
        float ss[4];
#pragma unroll
        for (int r = 0; r < 4; ++r) { float s = 0.f;
#pragma unroll
            for (int j = 0; j < 4; ++j) s += (v[r][j].x * v[r][j].x + v[r][j].y * v[r][j].y) + (v[r][j].z * v[r][j].z + v[r][j].w * v[r][j].w);
            ss[r] = s; }
#pragma unroll
        for (int o = 1; o < 64; o <<= 1) {
#pragma unroll
            for (int r = 0; r < 4; ++r) ss[r] += shx(ss[r], lane, o); }
#pragma unroll
        for (int r = 0; r < 4; ++r) { const float rr = rsqrtf(ss[r] * (1.f / DM) + EPS);
            u32x2* o8 = (u32x2*)(H + (size_t)(row0 + r) * DM) + lane;
#pragma unroll
            for (int j = 0; j < 4; ++j) { const f32x4 y = v[r][j] * rr * gm[j] + hh[j]; o8[64 * j] = pack4(y.x, y.y, y.z, y.w); } }
    }
}

__device__ __forceinline__ void qknorm_phase(const int tid, const int bid, bf16_t* QK, const float* qgain, const float* kgain) {
    const int lane = tid & 63, wave = __builtin_amdgcn_readfirstlane(tid >> 6), sub = lane >> 3, c8 = lane & 7;
    const int gw = bid * 8 + wave, NGW = gridDim.x * 8;
    float qg[8], kg[8];
#pragma unroll
    for (int x = 0; x < 8; ++x) { qg[x] = qgain[8 * c8 + x] * (0.125f * 1.4426950408889634f)  ; kg[x] = kgain[8 * c8 + x]; }
    for (int it = gw; it < 32768; it += NGW) {
        bf16x8 v[4];
#pragma unroll
        for (int u = 0; u < 4; ++u) v[u] = ldg8(QK + ((size_t)it * 32 + u * 8 + sub) * 64 + 8 * c8);
#pragma unroll
        for (int u = 0; u < 4; ++u) { float f[8]; unpack8(v[u], f); float ss = 0.f;
#pragma unroll
            for (int x = 0; x < 8; ++x) ss += f[x] * f[x];
            ss += shx(ss, lane, 1); ss += shx(ss, lane, 2); ss += shx(ss, lane, 4);
            const float r = rsqrtf(ss * (1.f / 64.f) + EPS); const bool isq = it < 16384;
#pragma unroll
            for (int x = 0; x < 8; ++x) f[x] *= r * (isq ? qg[x] : kg[x]);
            *(bf16x8*)(QK + ((size_t)it * 32 + u * 8 + sub) * 64 + 8 * c8) = pack8(f); }
    }
}
__device__ __forceinline__ void load_kfrag(bf16x8 (&kf)[8], const bf16_t* kbase  ) {
#pragma unroll
    for (int c2 = 0; c2 < 2; ++c2)
#pragma unroll
        for (int e = 0; e < 2; ++e) { const bf16_t* kp = kbase + (32 * c2 + 4 * e) * 64; kf[(c2 * 2 + e) * 2] = ldg8(kp); kf[(c2 * 2 + e) * 2 + 1] = ldg8(kp + 32); }
}
__device__ __forceinline__ void load_vfrag(bf16x8 (&vf)[8], const bf16_t* vbase  ) {
#pragma unroll
    for (int c2 = 0; c2 < 2; ++c2)
#pragma unroll
        for (int dt = 0; dt < 4; ++dt) vf[c2 * 4 + dt] = ldg8(vbase + dt * 16 * 64 + 32 * c2);
}
__device__ __forceinline__ void attn_a_phase(const int tid, const int bid, LAS unsigned char* lds, const bf16_t* QK, const bf16_t* VT, bf16_t* O, const float* relb) {
    const int lane = tid & 63, wave = __builtin_amdgcn_readfirstlane(tid >> 6), j = lane & 15, g = lane >> 4;
    const int vb = ((gridDim.x & 7) == 0) ? (bid & 7) * (gridDim.x >> 3) + (bid >> 3) : bid;
    const int gw = vb * 8 + wave, NGW = gridDim.x * 8;
    const int klane = (8 * (j >> 2) + (j & 3)) * 64 + 8 * g, vlane = j * 64 + 8 * g;
    for (int id = gw; id < 16384; id += NGW) {
        const int qt2 = id & 1, h = (id >> 1) & 15, ci = (id >> 5) & 127, b = id >> 12;
        const int tq0 = ci * 64 + qt2 * 32 + j;
        const size_t tokq = (size_t)b * SEQ + tq0;
        bf16x8 qb[2][2];
        { const bf16_t* qp = QK + ((size_t)(h * 512) + (tokq >> 6)) * 4096 + (tokq & 63) * 64 + 8 * g; qb[0][0] = ldg8(qp); qb[0][1] = ldg8(qp + 32); qb[1][0] = ldg8(qp + 16 * 64); qb[1][1] = ldg8(qp + 16 * 64 + 32); }
        float m_run[2] = {-INFINITY, -INFINITY}, l_run[2] = {0.f, 0.f};
        f32x4 o[2][4];
#pragma unroll
        for (int qs = 0; qs < 2; ++qs)
#pragma unroll
            for (int dt = 0; dt < 4; ++dt) o[qs][dt] = (f32x4){0.f, 0.f, 0.f, 0.f};
        LAS float* tb = (LAS float*)(lds + wave * 2048);
#pragma unroll
        for (int i = 0; i < 5; ++i) tb[lane + 64 * i] = relb[h * 320 + lane + 64 * i] * 1.4426950408889634f;
        const float bc = relb[h * 320 + 319] * 1.4426950408889634f;
        const int kt_lo = ci > 8 ? ci - 8 : 0;
        const bf16_t* kblk = QK + ((size_t)((16 + h) * 512) + b * 128) * 4096 + klane;
        const bf16_t* vblk = VT + ((size_t)(h * 512) + b * 128) * 4096 + vlane;
        bf16x8 kf[8]; load_kfrag(kf, kblk + (size_t)kt_lo * 4096);
        asm volatile("" :: "v"(kf[0]), "v"(kf[1]), "v"(kf[2]), "v"(kf[3]), "v"(kf[4]), "v"(kf[5]), "v"(kf[6]), "v"(kf[7]));
        for (int kt = kt_lo; kt <= ci; ++kt) {
            bf16x8 vf[8], kn[8];
            load_vfrag(vf, vblk + (size_t)kt * 4096);
            load_kfrag(kn, kblk + (size_t)(kt < ci ? kt + 1 : kt) * 4096);
            SB0();
            f32x4 sq[2][2][2];
#pragma unroll
            for (int qs = 0; qs < 2; ++qs)
#pragma unroll
                for (int c2 = 0; c2 < 2; ++c2)
#pragma unroll
                    for (int e = 0; e < 2; ++e) { f32x4 a = mfma16(kf[(c2 * 2 + e) * 2], qb[qs][0], (f32x4){0.f, 0.f, 0.f, 0.f}); sq[qs][c2][e] = mfma16(kf[(c2 * 2 + e) * 2 + 1], qb[qs][1], a); }
            const bool cbias = (ci - kt >= 5);
#pragma unroll
            for (int qs = 0; qs < 2; ++qs) {
                float tmax = -INFINITY;
                if (!cbias) { const int i0 = tq0 + 16 * qs - (kt * 64 + 8 * g) + 63;
#pragma unroll
                    for (int c2 = 0; c2 < 2; ++c2)
#pragma unroll
                        for (int x = 0; x < 8; ++x) { const int ix = i0 - 32 * c2 - x; sq[qs][c2][x >> 2][x & 3] += tb[ix > 319 ? 319 : ix]; }
                } else {
#pragma unroll
                    for (int c2 = 0; c2 < 2; ++c2)
#pragma unroll
                        for (int x = 0; x < 8; ++x) sq[qs][c2][x >> 2][x & 3] += bc; }
#pragma unroll
                for (int c2 = 0; c2 < 2; ++c2)
#pragma unroll
                    for (int x = 0; x < 8; ++x) tmax = fmaxf(tmax, sq[qs][c2][x >> 2][x & 3]);
                tmax = fmaxf(tmax, shx(tmax, lane, 16)); tmax = fmaxf(tmax, shx(tmax, lane, 32));
                const float m_new = fmaxf(m_run[qs], tmax), alpha = __builtin_amdgcn_exp2f(m_run[qs] - m_new);
                float lsum = 0.f; float pf[2][8];
#pragma unroll
                for (int c2 = 0; c2 < 2; ++c2)
#pragma unroll
                    for (int x = 0; x < 8; ++x) { const float pv = __builtin_amdgcn_exp2f(sq[qs][c2][x >> 2][x & 3] - m_new); pf[c2][x] = pv; lsum += pv; }
                l_run[qs] = l_run[qs] * alpha + lsum; m_run[qs] = m_new;
#pragma unroll
                for (int dt = 0; dt < 4; ++dt) o[qs][dt] *= alpha;
#pragma unroll
                for (int c2 = 0; c2 < 2; ++c2) { const bf16x8 pb = pack8(pf[c2]);
#pragma unroll
                    for (int dt = 0; dt < 4; ++dt) o[qs][dt] = mfma16(vf[c2 * 4 + dt], pb, o[qs][dt]); }
            }
            SB0();
            asm volatile("" :: "v"(kn[0]), "v"(kn[1]), "v"(kn[2]), "v"(kn[3]), "v"(kn[4]), "v"(kn[5]), "v"(kn[6]), "v"(kn[7]));
#pragma unroll
            for (int x = 0; x < 8; ++x) kf[x] = kn[x];
        }
#pragma unroll
        for (int qs = 0; qs < 2; ++qs) {
            float l = l_run[qs]; l += shx(l, lane, 16); l += shx(l, lane, 32);
            const float inv = 1.f / l;
#pragma unroll
            for (int dt = 0; dt < 4; ++dt) *(u32x2*)(O + (tokq + 16 * qs) * 1024 + h * 64 + dt * 16 + 4 * g) = pack4(o[qs][dt][0] * inv, o[qs][dt][1] * inv, o[qs][dt][2] * inv, o[qs][dt][3] * inv);
        }
    }
}

__device__ __forceinline__ void attn_d_phase(const int tid, const int bid, const bf16_t* QK, const bf16_t* VT, bf16_t* O) {
    const int lane = tid & 63, wave = __builtin_amdgcn_readfirstlane(tid >> 6), j = lane & 15, g = lane >> 4;
    const int vb = ((gridDim.x & 7) == 0) ? (bid & 7) * (gridDim.x >> 3) + (bid >> 3) : bid;
    const int gw = vb * 8 + wave, NGW = gridDim.x * 8;
    const int klane = (8 * (j >> 2) + (j & 3)) * 64 + 8 * g, vlane = j * 64 + 8 * g;
    for (int id = gw; id < 16384; id += NGW) {
        const int qt32 = id & 255, h = (id >> 8) & 15, b = id >> 12;
        const int tq0 = qt32 * 32 + j;
        const size_t tokq = (size_t)b * SEQ + tq0;
        const bf16_t* qp = QK + ((size_t)(h * 512) + (tokq >> 6)) * 4096 + (tokq & 63) * 64 + 8 * g;
        bf16x8 qb[2][2];
        qb[0][0] = ldg8(qp); qb[0][1] = ldg8(qp + 32); qb[1][0] = ldg8(qp + 16 * 64); qb[1][1] = ldg8(qp + 16 * 64 + 32);
        float carry[2] = {0.f, 0.f};
        f32x4 o[2][4];
#pragma unroll
        for (int qs = 0; qs < 2; ++qs)
#pragma unroll
            for (int dt = 0; dt < 4; ++dt) o[qs][dt] = (f32x4){0.f, 0.f, 0.f, 0.f};
        const bf16_t* kblk = QK + ((size_t)((16 + h) * 512) + b * 128) * 4096 + klane;
        const bf16_t* vblk = VT + ((size_t)(h * 512) + b * 128) * 4096 + vlane;
        const int kt0 = (qt32 * 32 + 31) >> 6;
        bf16x8 kf[8]; load_kfrag(kf, kblk + (size_t)kt0 * 4096);
        asm volatile("" :: "v"(kf[0]), "v"(kf[1]), "v"(kf[2]), "v"(kf[3]), "v"(kf[4]), "v"(kf[5]), "v"(kf[6]), "v"(kf[7]));
        for (int kt = kt0; kt >= 0; --kt) {
            bf16x8 vf[8], kn[8];
            load_vfrag(vf, vblk + (size_t)kt * 4096);
            load_kfrag(kn, kblk + (size_t)(kt > 0 ? kt - 1 : 0) * 4096);
            SB0();
            f32x4 sq[2][2][2];
#pragma unroll
            for (int qs = 0; qs < 2; ++qs)
#pragma unroll
                for (int c2 = 0; c2 < 2; ++c2)
#pragma unroll
                    for (int e = 0; e < 2; ++e) { f32x4 a = mfma16(kf[(c2 * 2 + e) * 2], qb[qs][0], (f32x4){0.f, 0.f, 0.f, 0.f}); sq[qs][c2][e] = mfma16(kf[(c2 * 2 + e) * 2 + 1], qb[qs][1], a); }
#pragma unroll
            for (int qs = 0; qs < 2; ++qs) {
                const int tq = tq0 + 16 * qs;
                float ln[2][8], ls[2][8], E[2][8], C[2], Gs[2];
#pragma unroll
                for (int c2 = 0; c2 < 2; ++c2)
#pragma unroll
                    for (int x = 0; x < 8; ++x) {
                        const float z = sq[qs][c2][x >> 2][x & 3] * (0.125f * 1.4426950408889634f);
                        const bool valid = (kt * 64 + 32 * c2 + 8 * g + x) < tq;
                        const float sp = fmaxf(z, 0.f) + __builtin_amdgcn_logf(1.f + __builtin_amdgcn_exp2f(-fabsf(z)));
                        ln[c2][x] = valid ? -sp : 0.f;
                        ls[c2][x] = valid ? (z - sp) : -INFINITY;
                    }
#pragma unroll
                for (int c2 = 0; c2 < 2; ++c2) { float run = 0.f;
#pragma unroll
                    for (int x = 7; x >= 0; --x) { E[c2][x] = run; run += ln[c2][x]; }
                    const float t1 = shx(run, lane, 16), t2 = shx(run, lane, 32), t3 = shx(run, lane, 48);
                    C[c2] = (run + t1) + (t2 + t3);
                    Gs[c2] = (((g ^ 1) > g) ? t1 : 0.f) + (((g ^ 2) > g) ? t2 : 0.f) + (((g ^ 3) > g) ? t3 : 0.f);
                }
                const float base1 = carry[qs] + Gs[1], base0 = carry[qs] + C[1] + Gs[0];
                float pf[2][8];
#pragma unroll
                for (int x = 0; x < 8; ++x) { pf[1][x] = __builtin_amdgcn_exp2f(ls[1][x] + E[1][x] + base1); pf[0][x] = __builtin_amdgcn_exp2f(ls[0][x] + E[0][x] + base0); }
                carry[qs] += C[0] + C[1];
#pragma unroll
                for (int c2 = 0; c2 < 2; ++c2) { const bf16x8 pb = pack8(pf[c2]);
#pragma unroll
                    for (int dt = 0; dt < 4; ++dt) o[qs][dt] = mfma16(vf[c2 * 4 + dt], pb, o[qs][dt]); }
            }
            SB0();
            asm volatile("" :: "v"(kn[0]), "v"(kn[1]), "v"(kn[2]), "v"(kn[3]), "v"(kn[4]), "v"(kn[5]), "v"(kn[6]), "v"(kn[7]));
#pragma unroll
            for (int x = 0; x < 8; ++x) kf[x] = kn[x];
            if (__all(fmaxf(carry[0], carry[1]) < -150.1f)) break;
        }
#pragma unroll
        for (int qs = 0; qs < 2; ++qs)
#pragma unroll
            for (int dt = 0; dt < 4; ++dt) *(u32x2*)(O + (tokq + 16 * qs) * 1024 + h * 64 + dt * 16 + 4 * g) = pack4(o[qs][dt][0], o[qs][dt][1], o[qs][dt][2], o[qs][dt][3]);
    }
}

__device__ __forceinline__ void b_p2_phase(const int tid, const int bid, LAS unsigned char* lds, int half, bf16_t* U, const bf16_t* VTB, const float* part, const float* w_s, const float* b_s, const float* v_gain) {
    const int lane = tid & 63, wave = __builtin_amdgcn_readfirstlane(tid >> 6), j = lane & 15, g = lane >> 4;
    LAS bf16_t* sW = (LAS bf16_t*)lds;
    LAS float* sR = (LAS float*)(lds + 34816);
    for (int unit = bid; unit < 1024; unit += gridDim.x) {
        const int w = unit >> 3, grp = unit & 7, wtok0 = w * 128;
        if (tid < 128) { const float* pp = part + (size_t)(wtok0 + tid) * 24; float s = 0.f;
#pragma unroll
            for (int q = 0; q < 24; ++q) s += pp[q];
            sR[tid] = rsqrtf(s * (1.f / 3072.f) + EPS); }
        __syncthreads();
#pragma unroll 8
        for (int idx = tid; idx < 16384; idx += 512) { const int i = idx >> 7, jj = idx & 127;
            const float val = ((i >> 6) >= (jj >> 6)) ? w_s[(size_t)(grp * 128 + i) * 128 + jj] * sR[jj] : 0.f;
            sW[i * 136 + jj] = (bf16_t)f2bf(val); }
        __syncthreads();
#pragma unroll 1
        for (int ct = wave; ct < 24; ct += 8) {
            f32x4 acc[8];
#pragma unroll
            for (int it = 0; it < 8; ++it) acc[it] = (f32x4){0.f, 0.f, 0.f, 0.f};
#pragma unroll
            for (int c4 = 0; c4 < 4; ++c4) {
                const int vrow = grp * 384 + ct * 16 + j; const bf16x8 va = ldg8(VTB + ((size_t)(vrow >> 6) * 256 + (wtok0 >> 6) + (c4 >> 1)) * 4096 + (vrow & 63) * 64 + 32 * (c4 & 1) + 8 * g);
#pragma unroll
                for (int it = 0; it < 8; ++it) { const bf16x8 wb = *(const LAS bf16x8*)(sW + (it * 16 + j) * 136 + 32 * c4 + 8 * g); acc[it] = mfma16(va, wb, acc[it]); }
            }
            const int ch0 = grp * 384 + ct * 16 + 4 * g;
            const f32x4 gn = *(const f32x4*)(v_gain + ch0);
#pragma unroll
            for (int it = 0; it < 8; ++it) { const int io = it * 16 + j; const float bs = b_s[grp * 128 + io];
                u32x2* up = (u32x2*)(U + ((size_t)half * 16384 + wtok0 + io) * 3072 + ch0); float uf[4]; unpack4(*up, uf);
                *up = pack4(uf[0] * (acc[it][0] * gn[0] + bs), uf[1] * (acc[it][1] * gn[1] + bs), uf[2] * (acc[it][2] * gn[2] + bs), uf[3] * (acc[it][3] * gn[3] + bs)); }
        }
        __syncthreads();
    }
}

__device__ __forceinline__ void c_p1_phase(const int tid, const int bid, LAS unsigned char* lds, bf16_t* QKR, const bf16_t* VT, const float* abuf, float* dbuf, bf16_t* ATT, bf16_t* DS, const float* wgate, const float* bgate) {
    const int lane = tid & 63, wave = __builtin_amdgcn_readfirstlane(tid >> 6), j = lane & 15, g = lane >> 4;
    LAS bf16_t* sQ = (LAS bf16_t*)lds;
    LAS bf16_t* sK = (LAS bf16_t*)(lds + 17408);
    LAS bf16_t* sKd = (LAS bf16_t*)(lds + 34816);
    LAS float* sA = (LAS float*)(lds + 53248);
    LAS float* sSeg = (LAS float*)(lds + 57344);
    const int kch = tid & 127, seg = tid >> 7;
    for (int unit = bid; unit < 2048; unit += gridDim.x) {
        const int c = unit & 127, h = (unit >> 7) & 3, b = unit >> 9;
        const size_t tok0 = (size_t)b * SEQ + (size_t)c * 64;
        for (int idx = tid; idx < 1024; idx += 512) sA[idx] = abuf[tok0 * 16 + idx];
        float wv[16];
#pragma unroll
        for (int r = 0; r < 16; ++r) wv[r] = wgate[r * 512 + h * 128 + kch];
        const float bg = bgate[h * 128 + kch];
        __syncthreads();
        float cum[16]; float run = 0.f;
#pragma unroll
        for (int i = 0; i < 16; ++i) { const int s = seg * 16 + i; float x = bg;
#pragma unroll
            for (int r = 0; r < 16; ++r) x += sA[s * 16 + r] * wv[r];
            const float la = -(fmaxf(-x, 0.f) + __logf(1.f + __expf(-fabsf(x)))) * (1.f / 16.f);
            run += la; cum[i] = run; }
        sSeg[seg * 128 + kch] = run;
        __syncthreads();
        const float s0 = sSeg[kch], s1 = sSeg[128 + kch], s2 = sSeg[256 + kch], s3 = sSeg[384 + kch];
        const float pre = (seg > 0 ? s0 : 0.f) + (seg > 1 ? s1 : 0.f) + (seg > 2 ? s2 : 0.f), blast = (s0 + s1) + (s2 + s3);
#pragma unroll
        for (int i = 0; i < 16; ++i) { const int s = seg * 16 + i; const float bb = pre + cum[i];
            bf16_t* qp = QKR + ((size_t)((2 * h + (kch >> 6)) * 512) + (tok0 >> 6)) * 4096 + s * 64 + (kch & 63);
            const float qv = bf2f(qp[0]), kv = bf2f(qp[(size_t)8 * 512 * 4096]);
            const bf16_t qb = (bf16_t)f2bf(qv * __expf(bb) * 0.08838834764831845f);
            qp[0] = qb; sQ[s * 136 + kch] = qb; sK[s * 136 + kch] = (bf16_t)f2bf(kv * __expf(-bb)); sKd[kch * 72 + s] = (bf16_t)f2bf(kv * __expf(blast - bb)); }
        if (seg == 0) dbuf[(size_t)unit * 128 + kch] = __expf(blast);
        __syncthreads();
        for (int tl = wave; tl < 16; tl += 8) { const int ti = tl >> 2, si = tl & 3;
            f32x4 a = (f32x4){0.f, 0.f, 0.f, 0.f};
            if (si <= ti) {
#pragma unroll
                for (int c4 = 0; c4 < 4; ++c4) { const bf16x8 ka = *(const LAS bf16x8*)(sK + (si * 16 + j) * 136 + 32 * c4 + 8 * g), qb = *(const LAS bf16x8*)(sQ + (ti * 16 + j) * 136 + 32 * c4 + 8 * g); a = mfma16(ka, qb, a); } }
            const int tt = ti * 16 + j, sb = si * 16 + 4 * g;
            *(u32x2*)(ATT + ((size_t)unit * 64 + tt) * 64 + sb) = pack4(sb + 0 <= tt ? a[0] : 0.f, sb + 1 <= tt ? a[1] : 0.f, sb + 2 <= tt ? a[2] : 0.f, sb + 3 <= tt ? a[3] : 0.f); }
        f32x4 acc[2][8];
#pragma unroll
        for (int vv = 0; vv < 2; ++vv)
#pragma unroll
            for (int kt = 0; kt < 8; ++kt) acc[vv][kt] = (f32x4){0.f, 0.f, 0.f, 0.f};
#pragma unroll
        for (int c2 = 0; c2 < 2; ++c2) { bf16x8 vb[2];
#pragma unroll
            for (int vv = 0; vv < 2; ++vv) { const int vrow = h * 256 + (2 * wave + vv) * 16 + j; vb[vv] = ldg8(VT + ((size_t)(vrow >> 6) * 512 + (tok0 >> 6)) * 4096 + (vrow & 63) * 64 + 32 * c2 + 8 * g); }
#pragma unroll
            for (int kt = 0; kt < 8; ++kt) { const bf16x8 ka = *(const LAS bf16x8*)(sKd + (kt * 16 + j) * 72 + 32 * c2 + 8 * g);
#pragma unroll
                for (int vv = 0; vv < 2; ++vv) acc[vv][kt] = mfma16(ka, vb[vv], acc[vv][kt]); } }
#pragma unroll
        for (int vv = 0; vv < 2; ++vv)
#pragma unroll
            for (int kt = 0; kt < 8; ++kt) *(u32x2*)(DS + ((size_t)unit * 256 + (2 * wave + vv) * 16 + j) * 128 + kt * 16 + 4 * g) = pack4(acc[vv][kt][0], acc[vv][kt][1], acc[vv][kt][2], acc[vv][kt][3]);
        __syncthreads();
    }
}
__device__ __forceinline__ void c_p2_phase(const int tid, const int bid, bf16_t* DS, const float* dbuf) {
    for (int item = bid * 512 + tid; item < 131072; item += gridDim.x * 512) {
        const int bh = item >> 13, e4 = (item & 8191) * 4, kch = e4 & 127;
        float S0 = 0.f, S1 = 0.f, S2 = 0.f, S3 = 0.f;
        for (int c0 = 0; c0 < 128; c0 += 16) {
            u32x2 dv[16]; f32x4 dd[16];
#pragma unroll
            for (int u = 0; u < 16; ++u) { const size_t unit = (size_t)bh * 128 + c0 + u; dv[u] = *(const u32x2*)(DS + unit * 32768 + e4); dd[u] = *(const f32x4*)(dbuf + unit * 128 + kch); }
#pragma unroll
            for (int u = 0; u < 16; ++u) { const size_t unit = (size_t)bh * 128 + c0 + u; float f[4]; unpack4(dv[u], f);
                *(u32x2*)(DS + unit * 32768 + e4) = pack4(S0, S1, S2, S3);
                S0 = S0 * dd[u][0] + f[0]; S1 = S1 * dd[u][1] + f[1]; S2 = S2 * dd[u][2] + f[2]; S3 = S3 * dd[u][3] + f[3]; }
        }
    }
}
__device__ __forceinline__ void c_p3_phase(const int tid, const int bid, const bf16_t* QKR, const bf16_t* VT, const bf16_t* ATT, const bf16_t* DS, bf16_t* O, const float* ogain) {
    const int lane = tid & 63, wave = __builtin_amdgcn_readfirstlane(tid >> 6), j = lane & 15, g = lane >> 4;
    const int vb = ((gridDim.x & 7) == 0) ? (bid & 7) * (gridDim.x >> 3) + (bid >> 3) : bid;
    const int gw = vb * 8 + wave, NGW = gridDim.x * 8;
    for (int id = gw; id < 4096; id += NGW) {
        const int tq2 = id & 1, unit = id >> 1, c = unit & 127, h = (unit >> 7) & 3, b = unit >> 9;
        const size_t tok0 = (size_t)b * SEQ + (size_t)c * 64;
        f32x4 acc[2][16];
#pragma unroll
        for (int qs = 0; qs < 2; ++qs)
#pragma unroll
            for (int vt = 0; vt < 16; ++vt) acc[qs][vt] = (f32x4){0.f, 0.f, 0.f, 0.f};
        if (c > 0) {
#pragma unroll 1
            for (int kc = 0; kc < 4; ++kc) {
                const bf16_t* qp = QKR + ((size_t)((2 * h + (kc >> 1)) * 512) + (tok0 >> 6)) * 4096 + (tq2 * 32 + j) * 64 + 32 * (kc & 1) + 8 * g;
                const bf16x8 qb0 = ldg8(qp), qb1 = ldg8(qp + 16 * 64);
#pragma unroll
                for (int vh = 0; vh < 2; ++vh) {
                    bf16x8 sa[8];
#pragma unroll
                    for (int v8 = 0; v8 < 8; ++v8) sa[v8] = ldg8(DS + ((size_t)unit * 256 + (vh * 8 + v8) * 16 + j) * 128 + 32 * kc + 8 * g);
                    SB0();
#pragma unroll
                    for (int v8 = 0; v8 < 8; ++v8) { acc[0][vh * 8 + v8] = mfma16(sa[v8], qb0, acc[0][vh * 8 + v8]); acc[1][vh * 8 + v8] = mfma16(sa[v8], qb1, acc[1][vh * 8 + v8]); }
                    SB0(); } }
        }
#pragma unroll 1
        for (int sc = 0; sc < 2; ++sc) {
            const bf16_t* ap = ATT + ((size_t)unit * 64 + tq2 * 32 + j) * 64 + 32 * sc + 8 * g;
            const bf16x8 ab0 = ldg8(ap), ab1 = ldg8(ap + 16 * 64);
#pragma unroll
            for (int vh = 0; vh < 2; ++vh) {
                bf16x8 va[8];
#pragma unroll
                for (int v8 = 0; v8 < 8; ++v8) { const int vt = vh * 8 + v8; va[v8] = ldg8(VT + ((size_t)((4 * h + (vt >> 2)) * 512) + (tok0 >> 6)) * 4096 + ((vt & 3) * 16 + j) * 64 + 32 * sc + 8 * g); }
                SB0();
#pragma unroll
                for (int v8 = 0; v8 < 8; ++v8) { acc[0][vh * 8 + v8] = mfma16(va[v8], ab0, acc[0][vh * 8 + v8]); acc[1][vh * 8 + v8] = mfma16(va[v8], ab1, acc[1][vh * 8 + v8]); }
                SB0(); } }
#pragma unroll
        for (int qs = 0; qs < 2; ++qs) {
            const size_t tok = tok0 + tq2 * 32 + qs * 16 + j;
            float ss = 0.f;
#pragma unroll
            for (int vt = 0; vt < 16; ++vt) ss += (acc[qs][vt][0] * acc[qs][vt][0] + acc[qs][vt][1] * acc[qs][vt][1]) + (acc[qs][vt][2] * acc[qs][vt][2] + acc[qs][vt][3] * acc[qs][vt][3]);
            ss += shx(ss, lane, 16); ss += shx(ss, lane, 32);
            const float rs = rsqrtf(ss * (1.f / 256.f) + EPS);
#pragma unroll
            for (int vt = 0; vt < 16; ++vt) { const int v0 = vt * 16 + 4 * g;
                float rf[4]; unpack4(*(const u32x2*)(QKR + ((size_t)((16 + 4 * h + (vt >> 2)) * 512) + (tok0 >> 6)) * 4096 + (tq2 * 32 + qs * 16 + j) * 64 + (v0 & 63)), rf);
                const f32x4 og = *(const f32x4*)(ogain + v0);
                float ov[4];
#pragma unroll
                for (int e = 0; e < 4; ++e) ov[e] = acc[qs][vt][e] * rs * og[e] * (rf[e] / (1.f + __expf(-rf[e])));
                *(u32x2*)(O + tok * 1024 + h * 256 + v0) = pack4(ov[0], ov[1], ov[2], ov[3]); }
        }
    }
}

#define XB_TMO      128
#define XB_XCNT(j)  (256  + 64 * (j))
#define XB_XSUB(j)  (1280 + 64 * (j))
#define XB_XGEN(j)  (2304 + 64 * (j))
#define XB_TOP      3328
#define XB_TOPGEN   3392
#define XCD_BAR_WORDS 3456
#define XB_SPIN_CAP (1u << 18)
__device__ __forceinline__ unsigned xb_ld(unsigned* p)              { return __hip_atomic_load(p, __ATOMIC_RELAXED, __HIP_MEMORY_SCOPE_AGENT); }
__device__ __forceinline__ unsigned xb_add(unsigned* p, unsigned v) { return __hip_atomic_fetch_add(p, v, __ATOMIC_RELAXED, __HIP_MEMORY_SCOPE_AGENT); }
__device__ __forceinline__ unsigned xb_xcc_id() { return (unsigned)__builtin_amdgcn_s_getreg((3 << 11) | 20) & 0xFu; }
#define XB_SPIN(cond, bar) do { unsigned _sp = 0; while (cond) { __builtin_amdgcn_s_sleep(1); \
    if ((++_sp & 255u) == 0u) { if (xb_ld(&(bar)[XB_TMO])) break; if (_sp > XB_SPIN_CAP) { atomicAdd(&(bar)[XB_TMO], 1u); break; } } } } while (0)
__device__ __forceinline__ void xcd_barrier_complete(unsigned* bar, unsigned x, unsigned& nloc, unsigned& nx) {
    const unsigned G = gridDim.x * gridDim.y * gridDim.z;
    unsigned sum, cnt, mine, sp = 0u;
    for (;;) {
        sum = 0u; cnt = 0u; mine = 0u;
#pragma unroll
        for (unsigned j = 0; j < 16; ++j) { const unsigned c = xb_ld(&bar[XB_XCNT(j)]); sum += c; cnt += (c > 0u) ? 1u : 0u; mine = (j == x) ? c : mine; }
        if (sum == G) break;
        __builtin_amdgcn_s_sleep(1);
        if ((++sp & 255u) == 0u) { if (xb_ld(&bar[XB_TMO])) break; if (sp > XB_SPIN_CAP) { atomicAdd(&bar[XB_TMO], 1u); break; } }
    }
    nloc = mine > 0u ? mine : 1u; nx = cnt > 0u ? cnt : 1u;
}
__device__ __forceinline__ void xcd_barrier(unsigned* bar, volatile LAS unsigned* st) {
    asm volatile("s_waitcnt vmcnt(0)" ::: "memory");
    __syncthreads();
    if (threadIdx.x == 0) {
        const unsigned x = xb_xcc_id();
        __builtin_amdgcn_s_waitcnt(0);
        unsigned nloc = st[0], nx = st[1];
        if (nloc == 0u) { xcd_barrier_complete(bar, x, nloc, nx); st[0] = nloc; st[1] = nx; }
        const unsigned old = xb_add(&bar[XB_XSUB(x)], 1u);
        const unsigned gen = old / nloc;
        if (old + 1u == (gen + 1u) * nloc) {
            __builtin_amdgcn_fence(__ATOMIC_RELEASE, "agent");
            asm volatile("s_waitcnt vmcnt(0)" ::: "memory");
            const unsigned og = xb_add(&bar[XB_TOP], 1u);
            const unsigned tg = og / nx;
            if (og + 1u == (tg + 1u) * nx) xb_add(&bar[XB_TOPGEN], 1u);
            else XB_SPIN(xb_ld(&bar[XB_TOPGEN]) == tg, bar);
            __builtin_amdgcn_fence(__ATOMIC_ACQUIRE, "agent");
            xb_add(&bar[XB_XGEN(x)], 1u);
            asm volatile("s_waitcnt vmcnt(0)" ::: "memory");
        } else {
            XB_SPIN(xb_ld(&bar[XB_XGEN(x)]) == gen, bar);
            __builtin_amdgcn_fence(__ATOMIC_ACQUIRE, "agent");
            asm volatile("s_waitcnt vmcnt(0)" ::: "memory");
        }
    }
    __syncthreads();
}
constexpr int LDS_BYTES = 139776;
__global__ void __launch_bounds__(512, 2) fwd_kernel(Params p) {
    extern __shared__ __attribute__((aligned(16))) unsigned char lds_raw[];
    LAS unsigned char* lds = (LAS unsigned char*)lds_raw;
    const int G = gridDim.x;
    const int ph_lo = p.ph_lo, ph_hi = p.ph_hi;
    volatile LAS unsigned* bst = (volatile LAS unsigned*)(lds + 131072);
    if (threadIdx.x == 0) { bst[0] = 0u; bst[1] = 0u; (void)xb_add((unsigned*)(p.ws + OFF_BAR) + XB_XCNT(xb_xcc_id()), 1u); }
    __syncthreads();
#pragma unroll 1
    for (int ph = ph_lo; ph < ph_hi; ++ph) {
        const CAS Params* pp = (const CAS Params*)__builtin_amdgcn_kernarg_segment_ptr(); asm volatile("" : "+s"(pp));
        unsigned char* ws = as_global(pp->ws);
#define IN(k) as_global(pp->in[k])
        float* const outp = as_global(pp->out);
        float* mod = (float*)(ws + OFF_MOD);
        bf16_t* Wt = (bf16_t*)(ws + OFF_W);
        bf16_t* Hb = (bf16_t*)(ws + OFF_H);
        unsigned char* big = ws + OFF_BIG;
        int tid = threadIdx.x; asm volatile("" : "+v"(tid));
        int bid = blockIdx.x; asm volatile("" : "+s"(bid));
        const PhTab* tp = &PHT; asm volatile("" : "+s"(tp));
        const int type = tp->t[ph][0], L = tp->t[ph][1], arg = tp->t[ph][2], xin_flag = tp->t[ph][3];
        const float* modL = mod + (size_t)L * 4 * 6144;
        const float* xcur = (xin_flag & 1) ? IN(0) : (const float*)outp;
#ifndef PHASE_MASK
#define PHASE_MASK 0xfff
#endif
#define PM(k) ((PHASE_MASK >> (k)) & 1)
        switch (type) {
        case 0: if (PM(0)) p0_phase(tid, bid, pp, ws, lds); break;
        case 1: if (PM(1) && arg < 2) {
            const float* gain = (arg == 0 ? IN(4) : IN(5)) + L * 1024;
            norm_phase(tid, bid, xcur, gain, modL + (arg == 0 ? 0 : 3072), modL + (arg == 0 ? 1024 : 4096), Hb);
        } break;
        case 2: if (PM(2)) {
            pg8::Gemm g{Hb, Wt + (L == 0 ? WA_IN : WD_IN), NTOK, 2048, 1024};
            pg8::EpiBf<0, false, true, 1, 512> E; E.part = nullptr; E.abuf = nullptr; E.qgain = nullptr; E.kgain = nullptr; E.lt = nullptr; E.O = (bf16_t*)(big + B_QK); E.ldc = 0;
            if (L == 0) { E.qgain = IN(9); E.kgain = IN(10); E.lt = (LAS float*)(lds + 131072 + 64); }
            pg8::StaticOrder S; S.init(NTOK, 2048, G, bid); pg8::gemm_phase<pg8::EpiBf<0, false, true, 1, 512>, pg8::StaticOrder, true, true>(tid, lds, g, S, E);
        } break;
        case 12: if (PM(2)) {
            const bf16_t* W = Wt + (arg == 0 ? WA_IN + (size_t)2048 * 1024 : (arg == 1 ? WD_IN + (size_t)2048 * 1024 : WC_IN + (size_t)2304 * 1024));
            pg8::Gemm g{W, Hb, 1024, NTOK, 1024};
            pg8::EpiBf<0, false, true, 512, 1> E; E.part = nullptr; E.abuf = nullptr; E.qgain = nullptr; E.kgain = nullptr; E.lt = nullptr; E.O = (bf16_t*)(big + B_VT); E.ldc = 0;
            pg8::StaticOrder S; S.init(1024, NTOK, G, bid); pg8::gemm_phase<pg8::EpiBf<0, false, true, 512, 1>, pg8::StaticOrder, true, true>(tid, lds, g, S, E);
        } break;
        case 13: if (PM(2)) {
            pg8::Gemm g{Hb, Wt + WC_IN, NTOK, 2304, 1024};
            pg8::EpiBf<0, false, true, 1, 512, 8> E; E.part = nullptr; E.abuf = (float*)(ws + OFF_ABUF); E.qgain = nullptr; E.kgain = nullptr; E.lt = nullptr; E.O = (bf16_t*)(big + B_QK); E.ldc = 0;
            pg8::StaticOrder S; S.init(NTOK, 2304, G, bid); pg8::gemm_phase<pg8::EpiBf<0, false, true, 1, 512, 8>, pg8::StaticOrder, true, true>(tid, lds, g, S, E);
        } break;
        case 10: if (PM(10)) {
            pg8::Gemm g{Hb, Wt + W_F1 + (size_t)L * 4194304, NTOK, 4096, 1024};
            pg8::EpiBf<2, false> E; E.part = nullptr; E.abuf = nullptr; E.qgain = nullptr; E.kgain = nullptr; E.lt = nullptr; E.O = (bf16_t*)(big + B_HID); E.ldc = 4096;
            pg8::StaticOrder S; S.init(NTOK, 4096, G, bid); pg8::gemm_phase<pg8::EpiBf<2, false>, pg8::StaticOrder, true, true>(tid, lds, g, S, E);
        } break;
        case 11: if (PM(11)) {
            pg8::Gemm g{Hb + (size_t)arg * 16384 * 1024, Wt + WB_IN, 16384, 3072, 1024};
            pg8::EpiBf<1, false> E; E.part = nullptr; E.abuf = nullptr; E.qgain = nullptr; E.kgain = nullptr; E.lt = nullptr; E.O = (bf16_t*)(big + B_U) + (size_t)arg * 16384 * 3072; E.ldc = 3072;
            pg8::StaticOrder S; S.init(16384, 3072, G, bid); pg8::gemm_phase<pg8::EpiBf<1, false>, pg8::StaticOrder, true, true>(tid, lds, g, S, E);
        } break;
        case 14: if (PM(11)) {
            pg8::Gemm g{Wt + WB_IN + (size_t)3072 * 1024, Hb + (size_t)arg * 16384 * 1024, 3072, 16384, 1024};
            pg8::EpiBf<1, true, true, 256, 1> E; E.part = (float*)(ws + OFF_PART); E.abuf = nullptr; E.qgain = nullptr; E.kgain = nullptr; E.lt = nullptr; E.O = (bf16_t*)(big + B_VTB); E.ldc = 0;
            pg8::StaticOrder S; S.init(3072, 16384, G, bid); pg8::gemm_phase<pg8::EpiBf<1, true, true, 256, 1>, pg8::StaticOrder, true, true>(tid, lds, g, S, E);
        } break;
        case 3: if (PM(3)) {
            pg8::Gemm g{Hb, Wt + (L == 0 ? WA_OUT : (L == 2 ? WC_OUT : WD_OUT)), NTOK, 1024, 1024};
            pg8::EpiResid E; E.xin = xcur; E.xout = outp; E.gate = modL + 2048;
            pg8::StaticOrder S; S.init(NTOK, 1024, G, bid); pg8::gemm_phase<pg8::EpiResid, pg8::StaticOrder, true, true>(tid, lds, g, S, E);
        } break;
        case 15: if (PM(3)) {
            pg8::Gemm g{(const bf16_t*)(big + B_U), Wt + WB_OUT, NTOK, 1024, 3072};
            pg8::EpiResid E; E.xin = xcur; E.xout = outp; E.gate = modL + 2048;
            pg8::StaticOrder S; S.init(NTOK, 1024, G, bid); pg8::gemm_phase<pg8::EpiResid, pg8::StaticOrder, true, true>(tid, lds, g, S, E);
        } break;
        case 16: if (PM(3)) {
            pg8::Gemm g{(const bf16_t*)(big + B_HID), Wt + W_F2 + (size_t)L * 4194304, NTOK, 1024, 4096};
            pg8::EpiResid E; E.xin = xcur; E.xout = outp; E.gate = modL + 5120;
            pg8::StaticOrder S; S.init(NTOK, 1024, G, bid); pg8::gemm_phase<pg8::EpiResid, pg8::StaticOrder, true, true>(tid, lds, g, S, E);
        } break;
        case 17: if (PM(4)) qknorm_phase(tid, bid, (bf16_t*)(big + B_QK), IN(9), IN(10)); break;
        case 4: if (PM(4)) attn_a_phase(tid, bid, lds, (const bf16_t*)(big + B_QK), (const bf16_t*)(big + B_VT), Hb, IN(11)); break;
        case 5: if (PM(5)) b_p2_phase(tid, bid, lds, arg, (bf16_t*)(big + B_U), (const bf16_t*)(big + B_VTB), (const float*)(ws + OFF_PART), IN(15), IN(16), IN(14)); break;
        case 6: if (PM(6)) c_p1_phase(tid, bid, lds, (bf16_t*)(big + B_QK), (const bf16_t*)(big + B_VT), (const float*)(ws + OFF_ABUF), (float*)(ws + OFF_DBUF), (bf16_t*)(big + B_ATT), (bf16_t*)(big + B_DS), IN(19), IN(20)); break;
        case 7: if (PM(7)) c_p2_phase(tid, bid, (bf16_t*)(big + B_DS), (const float*)(ws + OFF_DBUF)); break;
        case 8: if (PM(8)) c_p3_phase(tid, bid, (const bf16_t*)(big + B_QK), (const bf16_t*)(big + B_VT), (const bf16_t*)(big + B_ATT), (const bf16_t*)(big + B_DS), Hb, IN(21)); break;
        default: if (PM(9)) attn_d_phase(tid, bid, (const bf16_t*)(big + B_QK), (const bf16_t*)(big + B_VT), Hb); break;
        }
        if (ph + 1 < ph_hi && !(xin_flag & 2)) { if (ph_hi > 4096) cg::this_grid().sync(); else xcd_barrier((unsigned*)(ws + OFF_BAR), bst); }
    }
}


#ifdef DEBUG_DUMP
__global__ void dump_kernel(float* out, const unsigned char* ws, int which) {
    const unsigned char* big = ws + OFF_BIG;
    const bf16_t* QKR = (const bf16_t*)(big + B_QK); const bf16_t* VT = (const bf16_t*)(big + B_VT); const bf16_t* DS = (const bf16_t*)(big + B_DS); const bf16_t* ATT = (const bf16_t*)(big + B_ATT);
    const float* abuf = (const float*)(ws + OFF_ABUF); const float* dbuf = (const float*)(ws + OFF_DBUF); const bf16_t* Hb = (const bf16_t*)(ws + OFF_H);
    for (size_t i = (size_t)blockIdx.x * blockDim.x + threadIdx.x; i < (size_t)NTOK * DM; i += (size_t)gridDim.x * blockDim.x) {
        float v = 0.f;
        if (which == 0) v = bf2f(QKR[2 * i]) + bf2f(QKR[2 * i + 1]) + bf2f(VT[i]) + abuf[i & 524287];
        else if (which == 1) v = bf2f(DS[2 * i]) + bf2f(DS[2 * i + 1]) + bf2f(ATT[i & 8388607]) + dbuf[i & 262143] + bf2f(QKR[2 * i]) + bf2f(QKR[2 * i + 1]);
        else if (which == 2) v = bf2f(DS[2 * i]) + bf2f(DS[2 * i + 1]);
        else v = bf2f(Hb[i]);
        out[i] = v;
    }
}
#endif
extern "C" void kernel_launch(void* const* d_in, const int* in_sizes, int n_in, void* d_out, int out_size, void* d_ws, size_t ws_size, hipStream_t stream) {
    static int grid = 0;
    if (grid == 0) {
        if (n_in != 25 || out_size != NTOK * DM || ws_size < WS_NEED) { fprintf(stderr, "kernel_launch: unexpected shapes (n_in %d, out %d, ws %zu); nothing launched\n", n_in, out_size, ws_size); grid = -1; return; }
        int dev = 0, cus = 0, per_cu = 0;
        (void)hipGetDevice(&dev);
        (void)hipDeviceGetAttribute(&cus, hipDeviceAttributeMultiprocessorCount, dev);
        if (hipFuncSetAttribute((const void*)fwd_kernel, hipFuncAttributeMaxDynamicSharedMemorySize, LDS_BYTES) != hipSuccess) { fprintf(stderr, "kernel_launch: hipFuncSetAttribute failed\n"); grid = -1; return; }
        if (hipOccupancyMaxActiveBlocksPerMultiprocessor(&per_cu, (const void*)fwd_kernel, 512, LDS_BYTES) != hipSuccess || per_cu < 1) { fprintf(stderr, "kernel_launch: occupancy query says %d\n", per_cu); per_cu = 1; }
        (void)hipGetLastError();
        grid = cus * per_cu;
        if (grid < 1) grid = 256;
    }
    if (grid < 0) return;
    Params p{};
    for (int i = 0; i < 25; ++i) p.in[i] = (const float*)d_in[i];
    p.out = (float*)d_out; p.ws = (unsigned char*)d_ws;
#ifdef DEBUG_MEMSET
    (void)hipMemsetAsync(d_ws, 0, WS_NEED, stream); (void)hipMemsetAsync(d_out, 0, (size_t)out_size * 4, stream);
#endif
    (void)hipMemsetAsync((unsigned char*)d_ws + OFF_BAR, 0, XCD_BAR_WORDS * 4, stream);
#if MULTI_LAUNCH
#ifndef NPH_RUN
#define NPH_RUN NPHASE
#endif
    for (int ph = 0; ph < NPH_RUN; ++ph) { p.ph_lo = ph; p.ph_hi = ph + 1; hipLaunchKernelGGL(fwd_kernel, dim3(grid), dim3(512), LDS_BYTES, stream, p); }
#ifdef DEBUG_DUMP
    hipLaunchKernelGGL(dump_kernel, dim3(2048), dim3(256), 0, stream, (float*)d_out, (const unsigned char*)d_ws, DEBUG_DUMP);
#endif
#else
    p.ph_lo = 0; p.ph_hi = NPHASE;
    void* args[] = {&p};
    hipError_t e = hipLaunchCooperativeKernel((const void*)fwd_kernel, dim3(grid), dim3(512), args, LDS_BYTES, stream);
    if (e != hipSuccess) fprintf(stderr, "kernel_launch: cooperative launch failed: %s (grid %d)\n", hipGetErrorString(e), grid);
#endif
}
```
